# Optimizing an MI355X kernel written in HIP

```python
import jax, jax.numpy as jnp
from jax import lax
import numpy as np

D_MODEL = 1024
BATCH = 4
SEQ = 4096
DEPTH = 2

N_POOL_LAYERS = DEPTH // 2
N_ATTN_LAYERS = DEPTH - N_POOL_LAYERS
POOL_WINDOWS = (2, 4, 8, 16)
N_POOL_GROUPS = len(POOL_WINDOWS)
POOL_GROUP_DIM = D_MODEL // N_POOL_GROUPS
HEAD_DIM = 64
N_HEADS = D_MODEL // HEAD_DIM
Q_BLOCK = 128
N_EXPERTS = 256
TOP_K = 8
N_EXPERT_GROUPS = 8
TOPK_GROUPS = 4
D_EXPERT = D_MODEL // 4
D_SHARED = D_EXPERT
ROUTED_SCALE = 2.5
MOE_BLOCK = 128
DN_ALPHA = (2 * DEPTH) ** 0.25
DN_BETA = (8 * DEPTH) ** -0.25
LN_EPS = 1e-5
FORGET_BIAS_MEAN = 2.0

kernel_name = "yoco_pool_fox_moe_deepnorm"


def layer_norm(x, g, b):
    xf = x.astype(jnp.float32)
    mu = jnp.mean(xf, axis=-1, keepdims=True)
    var = jnp.mean(jnp.square(xf - mu), axis=-1, keepdims=True)
    return ((xf - mu) * lax.rsqrt(var + LN_EPS) * g.astype(jnp.float32) + b.astype(jnp.float32)).astype(x.dtype)


def multiscale_pool_mixer(x, w_group, scale):
    B, S, D = x.shape
    xg = x.reshape(B, S, N_POOL_GROUPS, POOL_GROUP_DIM).astype(jnp.float32)
    csum = jnp.pad(jnp.cumsum(xg, axis=1), ((0, 0), (1, 0), (0, 0), (0, 0)))
    pos = jnp.arange(1, S + 1, dtype=jnp.float32)
    outs = []
    for g, w in enumerate(POOL_WINDOWS):
        c = csum[:, :, g]
        lower = jnp.pad(c[:, :S + 1 - w], ((0, 0), (w - 1, 0), (0, 0)))
        mean = (c[:, 1:] - lower) / jnp.minimum(pos, float(w))[None, :, None]
        outs.append(mean - xg[:, :, g])
    mixed = jnp.stack(outs, axis=2).astype(x.dtype)
    y = jnp.einsum('bsgc,gcd->bsgd', mixed, w_group)
    return y.reshape(B, S, D) * scale


def shared_kv(xs, w_kvf, b_f):
    B, S, D = xs.shape
    kvf = xs @ w_kvf
    k = kvf[..., :D].reshape(B, S, N_HEADS, HEAD_DIM).transpose(0, 2, 1, 3)
    v = kvf[..., D:2 * D].reshape(B, S, N_HEADS, HEAD_DIM).transpose(0, 2, 1, 3)
    logf = jax.nn.log_sigmoid(kvf[..., 2 * D:].astype(jnp.float32) + b_f.astype(jnp.float32))
    F = jnp.cumsum(logf, axis=1).transpose(0, 2, 1)
    return k, v, F


def forgetting_attention(x, w_q, w_o, kt, vt, Fk):
    B, S, D = x.shape
    nq = S // Q_BLOCK
    q = (x @ w_q).reshape(B, nq, Q_BLOCK, N_HEADS, HEAD_DIM).transpose(1, 0, 3, 2, 4)
    Fq = Fk.reshape(B, N_HEADS, nq, Q_BLOCK).transpose(2, 0, 1, 3)
    kpos = jnp.arange(S)
    sm_scale = HEAD_DIM ** -0.5

    def block(args):
        i, qi, Fqi = args
        logits = jnp.einsum('bhqd,bhkd->bhqk', qi, kt, preferred_element_type=jnp.float32) * sm_scale
        logits = logits + Fqi[..., None] - Fk[:, :, None, :]
        qpos = i * Q_BLOCK + jnp.arange(Q_BLOCK)
        logits = jnp.where(kpos[None, :] <= qpos[:, None], logits, -jnp.inf)
        p = jax.nn.softmax(logits, axis=-1)
        return jnp.einsum('bhqk,bhkd->bhqd', p.astype(vt.dtype), vt)

    o = lax.map(block, (jnp.arange(nq), q, Fq))
    o = o.transpose(1, 0, 3, 2, 4).reshape(B, S, D)
    return o @ w_o


def moe(x2, w_router, b_router, w_gate_up, w_down, ws_gate_up, ws_down):
    N, D = x2.shape
    s = jax.nn.sigmoid((x2 @ w_router).astype(jnp.float32))
    sb = s + b_router.astype(jnp.float32)
    per_group = N_EXPERTS // N_EXPERT_GROUPS
    gscore = lax.top_k(sb.reshape(N, N_EXPERT_GROUPS, per_group), 2)[0].sum(-1)
    _, gidx = lax.top_k(gscore, TOPK_GROUPS)
    gmask = jax.nn.one_hot(gidx, N_EXPERT_GROUPS, dtype=jnp.float32).sum(1) > 0
    sb = jnp.where(jnp.repeat(gmask, per_group, axis=1), sb, -jnp.inf)
    _, eidx = lax.top_k(sb, TOP_K)
    gw = jnp.take_along_axis(s, eidx, axis=1)
    gw = gw / jnp.sum(gw, axis=-1, keepdims=True) * ROUTED_SCALE

    M = N * TOP_K
    n_blocks = -(-(M + N_EXPERTS * (MOE_BLOCK - 1)) // MOE_BLOCK)
    P = n_blocks * MOE_BLOCK
    flat_e = eidx.reshape(M)
    flat_tok = jnp.repeat(jnp.arange(N, dtype=jnp.int32), TOP_K)
    flat_w = gw.reshape(M)
    order = jnp.argsort(flat_e, stable=True)
    se = flat_e[order]
    counts = jnp.bincount(flat_e, length=N_EXPERTS)
    padded = (counts + MOE_BLOCK - 1) // MOE_BLOCK * MOE_BLOCK
    start = jnp.cumsum(counts) - counts
    pend = jnp.cumsum(padded)
    pstart = pend - padded
    dest = pstart[se] + (jnp.arange(M) - start[se])
    buf_tok = jnp.zeros((P,), jnp.int32).at[dest].set(flat_tok[order])
    buf_w = jnp.zeros((P,), x2.dtype).at[dest].set(flat_w[order].astype(x2.dtype))
    block_e = jnp.minimum(jnp.searchsorted(pend, jnp.arange(n_blocks) * MOE_BLOCK, side='right'), N_EXPERTS - 1)

    def body(acc, args):
        e, tok, wt = args
        xb = x2[tok]
        g_, u_ = jnp.split(xb @ w_gate_up[e], 2, axis=-1)
        y = (jax.nn.silu(g_) * u_) @ w_down[e]
        return acc.at[tok].add(y * wt[:, None]), None

    routed, _ = lax.scan(body, jnp.zeros_like(x2),
                         (block_e, buf_tok.reshape(n_blocks, MOE_BLOCK), buf_w.reshape(n_blocks, MOE_BLOCK)))
    sg, su = jnp.split(x2 @ ws_gate_up, 2, axis=-1)
    shared = (jax.nn.silu(sg) * su) @ ws_down
    return routed + shared


def setup_inputs(seed: int = 0) -> dict:
    key = jax.random.key(seed)
    ks = jax.random.split(key, 16)
    D, E, F, FS, H = D_MODEL, N_EXPERTS, D_EXPERT, D_SHARED, N_HEADS
    nrm = jax.random.normal
    x = nrm(ks[0], (BATCH, SEQ, D), jnp.float32)
    pool_w = nrm(ks[1], (N_POOL_LAYERS, N_POOL_GROUPS, POOL_GROUP_DIM, POOL_GROUP_DIM), jnp.float32) * (POOL_GROUP_DIM ** -0.5 * DN_BETA)
    pool_scale = 1.0 + 0.02 * nrm(ks[2], (N_POOL_LAYERS, D), jnp.float32)
    w_q = nrm(ks[3], (N_ATTN_LAYERS, D, D), jnp.float32) * D ** -0.5
    w_o = nrm(ks[4], (N_ATTN_LAYERS, D, D), jnp.float32) * (D ** -0.5 * DN_BETA)
    col_scale = jnp.concatenate([jnp.full((D,), D ** -0.5), jnp.full((D,), D ** -0.5 * DN_BETA), jnp.full((H,), 0.5 * D ** -0.5)]).astype(jnp.float32)
    w_kvf = nrm(ks[5], (D, 2 * D + H), jnp.float32) * col_scale
    b_f = FORGET_BIAS_MEAN + 0.1 * nrm(ks[6], (H,), jnp.float32)
    ln_g = 1.0 + 0.02 * nrm(ks[7], (DEPTH, 2, D), jnp.float32)
    ln_b = 0.02 * nrm(ks[8], (DEPTH, 2, D), jnp.float32)
    router_w = nrm(ks[9], (DEPTH, D, E), jnp.float32) * D ** -0.5
    router_b = 0.01 * nrm(ks[10], (DEPTH, E), jnp.float32)
    w_gate_up = nrm(ks[11], (DEPTH, E, D, 2 * F), jnp.float32) * D ** -0.5
    w_down = nrm(ks[12], (DEPTH, E, F, D), jnp.float32) * (F ** -0.5 * DN_BETA)
    ws_gate_up = nrm(ks[13], (DEPTH, D, 2 * FS), jnp.float32) * D ** -0.5
    ws_down = nrm(ks[14], (DEPTH, FS, D), jnp.float32) * (FS ** -0.5 * DN_BETA)
    return {"x": x, "pool_w": pool_w, "pool_scale": pool_scale, "w_q": w_q, "w_o": w_o,
            "w_kvf": w_kvf, "b_f": b_f, "ln_g": ln_g, "ln_b": ln_b, "router_w": router_w,
            "router_b": router_b, "w_gate_up": w_gate_up, "w_down": w_down,
            "ws_gate_up": ws_gate_up, "ws_down": ws_down}


def reference(x, pool_w, pool_scale, w_q, w_o, w_kvf, b_f, ln_g, ln_b, router_w, router_b,
              w_gate_up, w_down, ws_gate_up, ws_down):
    B, S, D = x.shape
    kt = vt = Fk = None
    for l in range(DEPTH):
        if l < N_POOL_LAYERS:
            mix = multiscale_pool_mixer(x, pool_w[l], pool_scale[l])
        else:
            if l == N_POOL_LAYERS:
                kt, vt, Fk = shared_kv(x, w_kvf, b_f)
            j = l - N_POOL_LAYERS
            mix = forgetting_attention(x, w_q[j], w_o[j], kt, vt, Fk)
        x = layer_norm(DN_ALPHA * x + mix, ln_g[l, 0], ln_b[l, 0])
        ffn = moe(x.reshape(B * S, D), router_w[l], router_b[l], w_gate_up[l], w_down[l],
                  ws_gate_up[l], ws_down[l])
        x = layer_norm(DN_ALPHA * x + ffn.reshape(B, S, D), ln_g[l, 1], ln_b[l, 1])
    return x
```

```cpp
#include <hip/hip_runtime.h>
#include <hip/hip_bf16.h>
#include <stdint.h>
#include <stdio.h>
#include <cmath>
namespace nk {
#define LAS __attribute__((address_space(3)))
typedef unsigned short bf16_t;
typedef short bf16x8 __attribute__((ext_vector_type(8)));
typedef short s16x4 __attribute__((ext_vector_type(4)));
typedef float f32x4 __attribute__((ext_vector_type(4)));
typedef float f32x2_t __attribute__((ext_vector_type(2)));
typedef __bf16 bf16x2_t __attribute__((ext_vector_type(2)));
typedef unsigned u32x2 __attribute__((ext_vector_type(2)));
typedef unsigned u32x4 __attribute__((ext_vector_type(4)));

constexpr int D = 1024, NB = 4, S = 4096, NTOK = NB * S, NH = 16, HD = 64, NE = 256, TOPK = 8, FE = 256;
constexpr int NKVF = 2 * D + NH;
constexpr int NTILE = NTOK / 64;
constexpr float ALPHA = 1.41421356237309515f, EPS = 1e-5f, ROUTED_SCALE = 2.5f, LOG2E = 1.4426950408889634f, C2 = 0.125f * 1.4426950408889634f;
constexpr float YSCALE = 16.0f;
constexpr int LCAP = NTOK;

constexpr int LDS_PANEL = 0;
constexpr int LDS_SCR = 131072;
constexpr int LDS_RED = LDS_SCR;
constexpr int LDS_BASE = LDS_SCR + 4096;
constexpr int LDS_MISC = LDS_SCR + 5120;
constexpr int LDS_XB = LDS_SCR + 12288 - 16;
constexpr int LDS_STAGE = LDS_SCR + 12288;
constexpr int LDS_TOTAL = 163840;

#define CFENCE() asm volatile("" ::: "memory")
#define LDS_BARRIER() do { asm volatile("s_waitcnt lgkmcnt(0)" ::: "memory"); __builtin_amdgcn_s_barrier(); asm volatile("" ::: "memory"); } while (0)
#define VPIN(x) asm volatile("" : "+v"(x))
__device__ __forceinline__ int launder(int v) { asm volatile("" : "+v"(v)); return v; }
__device__ __forceinline__ unsigned cvtpk(float lo, float hi) { f32x2_t v = {lo, hi}; bf16x2_t b = __builtin_convertvector(v, bf16x2_t); return __builtin_bit_cast(unsigned, b); }
__device__ __forceinline__ float bf_lo(unsigned u) { return __uint_as_float(u << 16); }
__device__ __forceinline__ float bf_hi(unsigned u) { return __uint_as_float(u & 0xffff0000u); }
__device__ __forceinline__ f32x4 mfma16(bf16x8 a, bf16x8 b, f32x4 c) { return __builtin_amdgcn_mfma_f32_16x16x32_bf16(a, b, c, 0, 0, 0); }
__device__ __forceinline__ float sigmoidf_(float x) { return 1.f / (1.f + __expf(-x)); }
__device__ __forceinline__ float siluf_(float x) { return x / (1.f + __expf(-x)); }

struct Params {
    const float* x; const float* pool_w; const float* pool_scale; const float* w_q; const float* w_o; const float* w_kvf; const float* b_f;
    const float* ln_g; const float* ln_b; const float* router_w; const float* router_b; const float* w_gate_up; const float* w_down;
    const float* ws_gate_up; const float* ws_down; float* out;
    unsigned* bar; int* cnt;
    unsigned* kmax2; unsigned* qmax2;
    bf16_t* wt_pool; bf16_t* wt_router; bf16_t* wt_wsgu; bf16_t* wt_wsd; bf16_t* wt_kvf; bf16_t* wt_q; bf16_t* wt_o;
    bf16_t* x1; bf16_t* x2; bf16_t* x3; bf16_t* Kb; bf16_t* Vb; bf16_t* Qb; bf16_t* Ob;
    float* Floc; float* Tsum;
    int* ltok; float* lw; int* pe; int* pp;
    bf16_t* Hb; unsigned char* Y8;
};

__device__ __forceinline__ void pretile(const float* __restrict__ W, int K, int N, int ld, bf16_t* __restrict__ out, int gtid, int gthreads) {
    const int KS = K / 32, items = (N / 16) * KS * 64;
    for (int it = gtid; it < items; it += gthreads) {
        const int lane = it & 63, tile = it >> 6, ks = tile % KS, nt = tile / KS;
        const float* src = W + (size_t)(ks * 32 + 8 * (lane >> 4)) * ld + nt * 16 + (lane & 15);
        u32x4 o;
        o.x = cvtpk(src[0], src[(size_t)ld]); o.y = cvtpk(src[(size_t)2 * ld], src[(size_t)3 * ld]);
        o.z = cvtpk(src[(size_t)4 * ld], src[(size_t)5 * ld]); o.w = cvtpk(src[(size_t)6 * ld], src[(size_t)7 * ld]);
        *(u32x4*)(out + (size_t)it * 8) = o;
    }
}
__device__ __forceinline__ void phase0a(const Params& p) {
    const int gtid = blockIdx.x * blockDim.x + threadIdx.x, gth = gridDim.x * blockDim.x;
    for (int g = 0; g < 4; ++g) pretile(p.pool_w + (size_t)g * 65536, 256, 256, 256, p.wt_pool + (size_t)g * 65536, gtid, gth);
    pretile(p.router_w, D, NE, NE, p.wt_router, gtid, gth);
}
__device__ __forceinline__ void phase0b(const Params& p) {
    const int gtid = blockIdx.x * blockDim.x + threadIdx.x, gth = gridDim.x * blockDim.x;
    pretile(p.router_w + (size_t)D * NE, D, NE, NE, p.wt_router + (size_t)D * NE, gtid, gth);
    for (int l = 0; l < 2; ++l) {
        pretile(p.ws_gate_up + (size_t)l * D * 512, D, 512, 512, p.wt_wsgu + (size_t)l * D * 512, gtid, gth);
        pretile(p.ws_down + (size_t)l * FE * D, FE, D, D, p.wt_wsd + (size_t)l * FE * D, gtid, gth);
    }
    pretile(p.w_kvf, D, NKVF, NKVF, p.wt_kvf, gtid, gth);
    pretile(p.w_q, D, D, D, p.wt_q, gtid, gth);
    pretile(p.w_o, D, D, D, p.wt_o, gtid, gth);
}

template <int NT, int NOFF, int NTOT, int PD = 4>
__device__ __forceinline__ void panel_mma(f32x4 (&acc)[NTOT][4], const LAS char* panel, const int row_bytes, const int kchunk0, const int ksteps,
                                          const bf16_t* __restrict__ wt, const int toff0, const int tstride, const int lane) {
    const int r = lane & 15, q = lane >> 4;
    const LAS char* arow = panel + r * row_bytes;
    const bf16x8* wp = (const bf16x8*)(wt + toff0) + lane;
    const int ts8 = tstride >> 3, last = ksteps - 1;
    bf16x8 b[PD][NT];
#pragma unroll
    for (int d = 0; d < PD; ++d)
#pragma unroll
        for (int nt = 0; nt < NT; ++nt) b[d][nt] = wp[nt * ts8 + (d < ksteps ? d : last) * 64];
    bf16x8 a[4], an[4];
#pragma unroll
    for (int mt = 0; mt < 4; ++mt) a[mt] = *(const LAS bf16x8*)(arow + mt * 16 * row_bytes + (((kchunk0 + q) ^ r) << 4));
    __builtin_amdgcn_sched_barrier(0);
#pragma unroll 1
    for (int ks = 0; ks < ksteps; ks += PD) {
#pragma unroll
        for (int d = 0; d < PD; ++d) {
            const int kn1 = ks + d + 1 < ksteps ? ks + d + 1 : last;
#pragma unroll
            for (int mt = 0; mt < 4; ++mt) an[mt] = *(const LAS bf16x8*)(arow + mt * 16 * row_bytes + (((kchunk0 + kn1 * 4 + q) ^ r) << 4));
#pragma unroll
            for (int nt = 0; nt < NT; ++nt)
#pragma unroll
                for (int mt = 0; mt < 4; ++mt) acc[NOFF + nt][mt] = mfma16(b[d][nt], a[mt], acc[NOFF + nt][mt]);
            const int kn = ks + d + PD < ksteps ? ks + d + PD : last;
#pragma unroll
            for (int nt = 0; nt < NT; ++nt) b[d][nt] = wp[nt * ts8 + kn * 64];
            __builtin_amdgcn_sched_barrier(0);
#pragma unroll
            for (int mt = 0; mt < 4; ++mt) a[mt] = an[mt];
        }
    }
    CFENCE();
}
template <int NT>
__device__ __forceinline__ void ln_stats(const f32x4 (&v)[NT][4], LAS float* red, int wid, int lane, float (&mean)[4], float (&rstd)[4]) {
    const int r = lane & 15, q = lane >> 4;
#pragma unroll
    for (int mt = 0; mt < 4; ++mt) {
        float s = 0.f, ss = 0.f;
#pragma unroll
        for (int nt = 0; nt < NT; ++nt)
#pragma unroll
            for (int i = 0; i < 4; ++i) { const float x = v[nt][mt][i]; s += x; ss = fmaf(x, x, ss); }
        s += __shfl_xor(s, 16); ss += __shfl_xor(ss, 16);
        s += __shfl_xor(s, 32); ss += __shfl_xor(ss, 32);
        if (q == 0) { red[(wid * 64 + mt * 16 + r) * 2] = s; red[(wid * 64 + mt * 16 + r) * 2 + 1] = ss; }
    }
    __syncthreads();
#pragma unroll
    for (int mt = 0; mt < 4; ++mt) {
        float s = 0.f, ss = 0.f;
#pragma unroll
        for (int w = 0; w < 8; ++w) { s += red[(w * 64 + mt * 16 + r) * 2]; ss += red[(w * 64 + mt * 16 + r) * 2 + 1]; }
        const float mu = s * (1.f / D); const float var = fmaxf(ss * (1.f / D) - mu * mu, 0.f);
        mean[mt] = mu; rstd[mt] = 1.0f / sqrtf(var + EPS);
    }
}

__device__ __forceinline__ void load_panel(const bf16_t* __restrict__ src, LAS char* panel, int tid_in) {
    const int tid = launder(tid_in);
#pragma unroll
    for (int i = 0; i < 16; ++i) {
        const int c = tid + i * 512, row = c >> 7, ch = c & 127;
        const u32x4 v = *(const u32x4*)(src + (size_t)row * D + ch * 8);
        *(LAS u32x4*)(panel + row * 2048 + ((ch ^ (row & 15)) << 4)) = v;
    }
}

__device__ __forceinline__ void store_panel(bf16_t* __restrict__ dst, const LAS char* panel, int tid_in) {
    const int tid = launder(tid_in);
#pragma unroll
    for (int i = 0; i < 16; ++i) {
        const int c = tid + i * 512, row = c >> 7, ch = c & 127;
        const u32x4 v = *(const LAS u32x4*)(panel + row * 2048 + ((ch ^ (row & 15)) << 4));
        *(u32x4*)(dst + (size_t)row * D + ch * 8) = v;
    }
}

template <int W>
__device__ __forceinline__ void poolmix_w(const float* __restrict__ x, int t0, int s0, LAS char* panel, int c) {
    float hx[W], hy[W];
#pragma unroll
    for (int j = 0; j < W; ++j) { hx[j] = 0.f; hy[j] = 0.f; }
    float sx = 0.f, sy = 0.f;
    if (s0 > 0) {
#pragma unroll
        for (int j = 0; j < W - 1; ++j) { const float2 v = *(const float2*)(x + (size_t)(t0 - (W - 1) + j) * D + c); hx[j] = v.x; hy[j] = v.y; sx += v.x; sy += v.y; }
    }
    for (int mb = 0; mb < 4; ++mb) {
        float2 v[16];
#pragma unroll
        for (int j = 0; j < 16; ++j) v[j] = *(const float2*)(x + (size_t)(t0 + mb * 16 + j) * D + c);
#pragma unroll
        for (int j = 0; j < 16; ++j) {
            const int m = mb * 16 + j; constexpr int dummy = 0; (void)dummy;
            const int slot = (j + W - 1) % W;
            sx += v[j].x - hx[slot]; sy += v[j].y - hy[slot]; hx[slot] = v[j].x; hy[slot] = v[j].y;
            const int n = (s0 + m + 1 < W) ? (s0 + m + 1) : W; const float inv = 1.0f / (float)n;
            const unsigned pk = cvtpk(sx * inv - v[j].x, sy * inv - v[j].y);
            *(LAS unsigned*)(panel + m * 2048 + ((((c >> 3)) ^ (m & 15)) << 4) + (c & 7) * 2) = pk;
        }
    }
}

__device__ __forceinline__ void route_topk(const Params& p, int l, LAS char* scb, int t0, int tid) {
    const int lane = tid & 63, tk = tid >> 3, g = tid & 7;
    float v[32];
    const LAS f32x4* sp = (const LAS f32x4*)(scb + tk * 1040 + g * 128);
    const float4* bp = (const float4*)(p.router_b + l * NE + g * 32);
#pragma unroll
    for (int i = 0; i < 8; ++i) { const f32x4 s4 = sp[i]; const float4 b4 = bp[i]; v[4 * i] = s4[0] + b4.x; v[4 * i + 1] = s4[1] + b4.y; v[4 * i + 2] = s4[2] + b4.z; v[4 * i + 3] = s4[3] + b4.w; }
    float m1 = -INFINITY, m2 = -INFINITY;
#pragma unroll
    for (int i = 0; i < 32; ++i) { const float xv = v[i]; m2 = fmaxf(m2, fminf(m1, xv)); m1 = fmaxf(m1, xv); }
    const float gs = m1 + m2;
    int rank = 0;
#pragma unroll
    for (int j = 0; j < 8; ++j) { const float og = __shfl(gs, (lane & ~7) + j); rank += ((og > gs) || (og == gs && j < g)) ? 1 : 0; }
    const bool sel = rank < 4;
    unsigned taken = 0u; int my_e = 0;
#pragma unroll 1
    for (int round = 0; round < TOPK; ++round) {
        float bv = -INFINITY; int bi = 0;
#pragma unroll
        for (int i = 0; i < 32; ++i) { const bool ok = !((taken >> i) & 1u) && (v[i] > bv); bv = ok ? v[i] : bv; bi = ok ? i : bi; }
        if (!sel) bv = -INFINITY;
        int be = g * 32 + bi;
#pragma unroll
        for (int off = 1; off < 8; off <<= 1) { const float ov = __shfl_xor(bv, off); const int oe = __shfl_xor(be, off); const bool tk2 = (ov > bv) || (ov == bv && oe < be); bv = tk2 ? ov : bv; be = tk2 ? oe : be; }
        if ((be >> 5) == g) taken |= 1u << (be & 31);
        if (round == g) my_e = be;
    }
    const float sk = *(const LAS float*)(scb + tk * 1040 + my_e * 4);
    float sum = sk; sum += __shfl_xor(sum, 1); sum += __shfl_xor(sum, 2); sum += __shfl_xor(sum, 4);
    const float gw = sk / sum * ROUTED_SCALE;
    const int t = t0 + tk;
    const int pos = atomicAdd(p.cnt + l * NE + my_e, 1);
    p.ltok[(size_t)my_e * LCAP + pos] = t * TOPK + g; p.lw[(size_t)my_e * LCAP + pos] = gw;
    p.pe[t * TOPK + g] = my_e; p.pp[t * TOPK + g] = pos;
}

__device__ __forceinline__ void ln_route_tail(const Params& p, int l, int which_ln, f32x4 (&v)[8][4], const int colbase, bf16_t* __restrict__ xout, LAS char* lds, int t0, int tid_in) {
    int tid = launder(tid_in);
    const int wid = __builtin_amdgcn_readfirstlane(tid >> 6), lane = tid & 63, r = lane & 15, q = lane >> 4;
    LAS char* panel = lds + LDS_PANEL; LAS float* red = (LAS float*)(lds + LDS_RED);
    float mean[4], rstd[4];
    ln_stats<8>(v, red, wid, lane, mean, rstd);
    const float* lg = p.ln_g + (l * 2 + which_ln) * D; const float* lb = p.ln_b + (l * 2 + which_ln) * D;
#pragma unroll
    for (int nt = 0; nt < 8; ++nt) {
        const int n = colbase + nt * 16 + 4 * q;
        const float4 g4 = *(const float4*)(lg + n), b4 = *(const float4*)(lb + n);
#pragma unroll
        for (int mt = 0; mt < 4; ++mt) {
            const int m = mt * 16 + r;
            const float y0 = (v[nt][mt][0] - mean[mt]) * rstd[mt] * g4.x + b4.x, y1 = (v[nt][mt][1] - mean[mt]) * rstd[mt] * g4.y + b4.y;
            const float y2 = (v[nt][mt][2] - mean[mt]) * rstd[mt] * g4.z + b4.z, y3 = (v[nt][mt][3] - mean[mt]) * rstd[mt] * g4.w + b4.w;
            u32x2 o; o.x = cvtpk(y0, y1); o.y = cvtpk(y2, y3);
            *(LAS u32x2*)(panel + m * 2048 + ((((n >> 3)) ^ r) << 4) + (n & 7) * 2) = o;
        }
        CFENCE();
    }
    __syncthreads();
    store_panel(xout + (size_t)t0 * D, panel, tid);
    f32x4 ra[2][4];
#pragma unroll
    for (int nt = 0; nt < 2; ++nt)
#pragma unroll
        for (int mt = 0; mt < 4; ++mt) ra[nt][mt] = (f32x4){0.f, 0.f, 0.f, 0.f};
    panel_mma<2, 0, 2>(ra, panel, 2048, 0, 32, p.wt_router + (size_t)l * D * NE, (2 * wid) * 32 * 512, 32 * 512, lane);
    __syncthreads();
    LAS char* scb = panel;
#pragma unroll
    for (int nt = 0; nt < 2; ++nt)
#pragma unroll
        for (int mt = 0; mt < 4; ++mt) {
            f32x4 s4; s4[0] = sigmoidf_(ra[nt][mt][0]); s4[1] = sigmoidf_(ra[nt][mt][1]); s4[2] = sigmoidf_(ra[nt][mt][2]); s4[3] = sigmoidf_(ra[nt][mt][3]);
            *(LAS f32x4*)(scb + (mt * 16 + r) * 1040 + (32 * wid + nt * 16 + 4 * q) * 4) = s4;
        }
    __syncthreads();
    route_topk(p, l, scb, t0, launder(tid));
    __syncthreads();
}

__device__ __forceinline__ void phase1(const Params& p, LAS char* lds) {
    LAS char* panel = lds + LDS_PANEL;
    for (int tile = blockIdx.x; tile < NTILE; tile += gridDim.x) {
        const int tid = launder(threadIdx.x), wid = __builtin_amdgcn_readfirstlane(tid >> 6), lane = tid & 63, r = lane & 15, q = lane >> 4;
        const int t0 = tile * 64, s0 = t0 % S;
        { const int c = 2 * tid;
          switch (wid >> 1) { case 0: poolmix_w<2>(p.x, t0, s0, panel, c); break; case 1: poolmix_w<4>(p.x, t0, s0, panel, c); break;
                              case 2: poolmix_w<8>(p.x, t0, s0, panel, c); break; default: poolmix_w<16>(p.x, t0, s0, panel, c); break; } }
        __syncthreads();
        f32x4 acc[8][4];
#pragma unroll
        for (int nt = 0; nt < 8; ++nt)
#pragma unroll
            for (int mt = 0; mt < 4; ++mt) acc[nt][mt] = (f32x4){0.f, 0.f, 0.f, 0.f};
        const int g = wid >> 1, hf = wid & 1;
        panel_mma<4, 0, 8>(acc, panel, 2048, g * 32, 8, p.wt_pool, g * 65536 + (hf * 8) * 8 * 512, 8 * 512, lane);
        panel_mma<4, 4, 8>(acc, panel, 2048, g * 32, 8, p.wt_pool, g * 65536 + (hf * 8 + 4) * 8 * 512, 8 * 512, lane);
        const int colbase = g * 256 + hf * 128;
#pragma unroll
        for (int nt = 0; nt < 8; ++nt) {
            const int n = colbase + nt * 16 + 4 * q;
            const float4 sc = *(const float4*)(p.pool_scale + n);
#pragma unroll
            for (int mt = 0; mt < 4; ++mt) {
                const float4 xr = *(const float4*)(p.x + (size_t)(t0 + mt * 16 + r) * D + n);
                acc[nt][mt][0] = fmaf(acc[nt][mt][0], sc.x, ALPHA * xr.x); acc[nt][mt][1] = fmaf(acc[nt][mt][1], sc.y, ALPHA * xr.y);
                acc[nt][mt][2] = fmaf(acc[nt][mt][2], sc.z, ALPHA * xr.z); acc[nt][mt][3] = fmaf(acc[nt][mt][3], sc.w, ALPHA * xr.w);
            }
            VPIN(acc[nt][0]); VPIN(acc[nt][1]); VPIN(acc[nt][2]); VPIN(acc[nt][3]); CFENCE();
        }
        ln_route_tail(p, 0, 0, acc, colbase, p.x1, lds, t0, tid);
    }
}
constexpr int EXP_RS = 288, EXP_BUF = 64 * EXP_RS;
__device__ __forceinline__ int exp_g(int k) { return (k & 3) | (((k >> 3) & 1) << 2); }
constexpr int XA_BUF = 8192, XA_WAVE = 2 * XA_BUF;
constexpr int XW_OFF = 131072, XW_RS = 256, XW_BUF = 64 * XW_RS;
__device__ __forceinline__ void dma16_asm(unsigned voff, const void* sbase, unsigned lds_dst) {
    unsigned keep;
    asm volatile("s_mov_b32 %0, m0\n\ts_mov_b32 m0, %3\n\ts_nop 0\n\tglobal_load_lds_dwordx4 %1, %2\n\ts_mov_b32 m0, %0" : "=&s"(keep) : "v"(voff), "s"(sbase), "s"(lds_dst) : "memory");
}
template <int NMT, int PM>
__device__ __forceinline__ void expert_loop(f32x4 (&acc)[8][4], LAS char* lds, const bf16_t* __restrict__ A, const unsigned (&aoffp)[8], const int nsteps,
                                            const float* __restrict__ wbase, const unsigned wvoff, const int ldw, LAS char* wdst, const int wslot, const LAS char* rb3_in,
                                            const unsigned adma, const LAS char* aread0_in) {
    const int last = nsteps - 1;
    f32x4 wa[4], wb[4];
    const size_t wstep = (size_t)64 * ldw * 4;
#define W_LOAD1(dst, st, i) if (PM != 5) { const char* b_ = (const char*)wbase + (size_t)(st) * wstep + (size_t)((i) >> 1) * 2 * ldw * 4; \
        if ((i) & 1) asm volatile("global_load_dwordx4 %0, %1, %2 offset:2048" : "=&v"(dst[i]) : "v"(wvoff), "s"(b_) : "memory"); \
        else asm volatile("global_load_dwordx4 %0, %1, %2" : "=&v"(dst[i]) : "v"(wvoff), "s"(b_) : "memory"); }
#define W_STORE1(src, bufoff, i) if (PM != 5) { u32x2 o; o.x = cvtpk(src[i][0], src[i][1]); o.y = cvtpk(src[i][2], src[i][3]); *(LAS u32x2*)(wdst + (bufoff) + (i) * XW_RS + ((wslot ^ (i)) << 5)) = o; }
#define A_DMA1(st, abuf, pc) if (PM != 7 && (pc) < 2 * NMT) { dma16_asm(aoffp[pc], (const char*)A + (size_t)(st) * 128, adma + (abuf) + (pc) * 1024); }
#define WAIT_TOP(w) asm volatile("s_waitcnt vmcnt(4)" : "+v"(w[0]), "+v"(w[1]), "+v"(w[2]), "+v"(w[3]) :: "memory")
#define B_READ(dst, cur, ks, nt) { const LAS char* bp = (const LAS char*)((unsigned)(size_t)rb3_in ^ ((nt) << 5)) + (cur) + (ks) * 32 * XW_RS; \
        const s16x4 lo = __builtin_bit_cast(s16x4, __builtin_amdgcn_ds_read_tr16_b64_v4i16((LAS s16x4*)bp)); \
        const s16x4 hi = __builtin_bit_cast(s16x4, __builtin_amdgcn_ds_read_tr16_b64_v4i16((LAS s16x4*)(bp + 4 * XW_RS))); \
        dst = (bf16x8){lo[0], lo[1], lo[2], lo[3], hi[0], hi[1], hi[2], hi[3]}; }
#define MMA_STEP(wcur, wnxt, acur, anxt, wst, sa, sw) { \
        const LAS char* ar0 = aread0_in + (acur); const LAS char* ar1 = (const LAS char*)((unsigned)(size_t)ar0 ^ 64u); \
        bf16x8 af[NMT], bq, bn; \
        _Pragma("unroll") for (int mt = 0; mt < NMT; ++mt) af[mt] = *(const LAS bf16x8*)(ar0 + mt * 2048); \
        B_READ(bq, wcur, 0, 0); \
        _Pragma("unroll") for (int g = 0; g < 16; ++g) { \
            if (g < 15) { B_READ(bn, wcur, (g + 1) >> 3, (g + 1) & 7); } \
            if (PM != 4) { _Pragma("unroll") for (int mt = 0; mt < NMT; ++mt) acc[g & 7][mt] = mfma16(bq, af[mt], acc[g & 7][mt]); } else asm volatile("" :: "v"(bq), "v"(af[0])); \
            if (g == 7) { _Pragma("unroll") for (int mt = 0; mt < NMT; ++mt) af[mt] = *(const LAS bf16x8*)(ar1 + mt * 2048); } \
            if (g < 4) { W_STORE1(wst, wnxt, g); } else if (g < 12) { A_DMA1(sa, anxt, g - 4); } else { W_LOAD1(wst, sw, g - 12); } \
            bq = bn; \
            __builtin_amdgcn_sched_barrier(0); } }
    W_LOAD1(wa, 0, 0); W_LOAD1(wa, 0, 1); W_LOAD1(wa, 0, 2); W_LOAD1(wa, 0, 3);
#pragma unroll
    for (int pc = 0; pc < 8; ++pc) A_DMA1(0, 0, pc);
    { const int s1 = 1 < nsteps ? 1 : last; W_LOAD1(wb, s1, 0); W_LOAD1(wb, s1, 1); W_LOAD1(wb, s1, 2); W_LOAD1(wb, s1, 3); }
    asm volatile("s_waitcnt vmcnt(%4)" : "+v"(wa[0]), "+v"(wa[1]), "+v"(wa[2]), "+v"(wa[3]) : "n"(2 * NMT + 4) : "memory");
    W_STORE1(wa, 0, 0); W_STORE1(wa, 0, 1); W_STORE1(wa, 0, 2); W_STORE1(wa, 0, 3);
    { const int s2 = 2 < nsteps ? 2 : last; W_LOAD1(wa, s2, 0); W_LOAD1(wa, s2, 1); W_LOAD1(wa, s2, 2); W_LOAD1(wa, s2, 3); }
    LDS_BARRIER();
#pragma unroll 1
    for (int s = 0; s < nsteps; s += 2) {
        WAIT_TOP(wb);
        { const int sw = s + 3 < nsteps ? s + 3 : last; MMA_STEP(0, XW_BUF, 0, XA_BUF, wb, s + 1, sw); }
        LDS_BARRIER();
        WAIT_TOP(wa);
        { const int sa = s + 2 < nsteps ? s + 2 : last, sw = s + 4 < nsteps ? s + 4 : last; MMA_STEP(XW_BUF, 0, XA_BUF, 0, wa, sa, sw); }
        LDS_BARRIER();
    }
    asm volatile("s_waitcnt vmcnt(0)" ::: "memory");
    LDS_BARRIER();
#undef W_LOAD1
#undef W_STORE1
#undef A_DMA1
#undef WAIT_TOP
#undef B_READ
#undef MMA_STEP
}
template <int PM = 0>
__device__ __forceinline__ void expert_gemm1(f32x4 (&acc)[8][4], LAS char* lds, const bf16_t* __restrict__ A, const unsigned (&aoffp)[8],
                                             const float* __restrict__ W, const int ldw, const int col0, const int col1, const int nmt, const int tid) {
    const int lane = tid & 63, r = lane & 15, q = lane >> 4, wid = __builtin_amdgcn_readfirstlane(tid >> 6);
    const int n4 = tid & 31, kp = tid >> 5;
    const unsigned wvoff = (unsigned)(((4 * kp) * ldw + (n4 < 16 ? col0 + 4 * n4 : col1 + 4 * (n4 - 16))) * 4);
    LAS char* wdst = lds + XW_OFF + (4 * kp) * XW_RS + (n4 & 3) * 8;
    const int wslot = (n4 >> 2) ^ (((kp >> 1) & 1) << 2);
    const int rrow = 8 * q + (r >> 2);
    const LAS char* rb3 = lds + XW_OFF + rrow * XW_RS + (r & 3) * 8 + (exp_g(rrow) << 5);
    const unsigned adma = (unsigned)(size_t)(lds + wid * XA_WAVE);
    const LAS char* aread0 = lds + wid * XA_WAVE + r * 128 + (((q ^ (r >> 1)) & 7) << 4);
    const int nsteps = 16;
    switch (nmt) {
        case 1: expert_loop<1, PM>(acc, lds, A, aoffp, nsteps, W, wvoff, ldw, wdst, wslot, rb3, adma, aread0); break;
        case 2: expert_loop<2, PM>(acc, lds, A, aoffp, nsteps, W, wvoff, ldw, wdst, wslot, rb3, adma, aread0); break;
        case 3: expert_loop<3, PM>(acc, lds, A, aoffp, nsteps, W, wvoff, ldw, wdst, wslot, rb3, adma, aread0); break;
        default: expert_loop<4, PM>(acc, lds, A, aoffp, nsteps, W, wvoff, ldw, wdst, wslot, rb3, adma, aread0); break;
    }
}

constexpr int EMT = 4;
template <int PM>
__device__ __forceinline__ void gemm1_unit(const Params& p, int l, int e, int cnt, int base, int j_in, LAS char* lds, int tid_in) {
    const int j = (PM == 1) ? 0 : j_in;
    const float* w1 = p.w_gate_up + ((size_t)l * NE + e) * D * 512;
    const int* ltok = p.ltok + (size_t)e * LCAP; const float* lw = p.lw + (size_t)e * LCAP;
    const bf16_t* xin = l ? p.x3 : p.x1;
    for (int r0 = 0; r0 < cnt; r0 += 128 * EMT) {
        const int tid = launder(tid_in), wid = __builtin_amdgcn_readfirstlane(tid >> 6), lane = tid & 63, r = lane & 15, q = lane >> 4;
        const int nrows = (cnt - r0 < 128 * EMT) ? (cnt - r0) : 128 * EMT;
        const int nmt = (nrows + 127) >> 7, wrb = r0 + wid * nmt * 16;
        unsigned aoffp[8];
#pragma unroll
        for (int pc = 0; pc < 8; ++pc) {
            const int row = wrb + 8 * pc + (lane >> 3);
            const int rr = ((pc < 2 * nmt) && (row < r0 + nrows)) ? row : r0;
            aoffp[pc] = (PM == 2 ? 0u : (unsigned)(ltok[rr] >> 3)) * (D * 2) + (unsigned)(((lane & 7) ^ (4 * (pc & 1) + (lane >> 4))) << 4);
        }
        f32x4 acc[8][EMT];
#pragma unroll
        for (int nt = 0; nt < 8; ++nt)
#pragma unroll
            for (int mt = 0; mt < EMT; ++mt) acc[nt][mt] = (f32x4){0.f, 0.f, 0.f, 0.f};
        expert_gemm1<PM>(acc, lds, xin, aoffp, w1, 512, 64 * j, 256 + 64 * j, nmt, tid);
        {
            const int tid2 = launder(tid), lane2 = tid2 & 63, r2 = lane2 & 15, q2 = lane2 >> 4;
            const int wrb2 = r0 + __builtin_amdgcn_readfirstlane(tid2 >> 6) * nmt * 16;
#pragma unroll
            for (int mt = 0; mt < EMT; ++mt) {
                const int row = wrb2 + mt * 16 + r2;
                if ((mt < nmt) && (row < r0 + nrows)) {
                    const float gw = lw[row];
                    bf16_t* hp = (PM ? p.Ob + (size_t)((base + row) & 1023) * FE : p.Hb + (size_t)(base + row) * FE) + 64 * j_in + 4 * q2;
#pragma unroll
                    for (int nt = 0; nt < 4; ++nt) {
                        const f32x4 g = acc[nt][mt], u = acc[nt + 4][mt];
                        u32x2 o; o.x = cvtpk(siluf_(g[0]) * u[0] * gw, siluf_(g[1]) * u[1] * gw); o.y = cvtpk(siluf_(g[2]) * u[2] * gw, siluf_(g[3]) * u[3] * gw);
                        *(u32x2*)(hp + nt * 16) = o;
                    }
                }
            }
        }
    }
}
__device__ __forceinline__ void expert_bases(const int* __restrict__ cnt, LAS int* basel, int tid_in) {
    const int tid = launder(tid_in);
    if (tid < 64) {
        const int4 c = *(const int4*)(cnt + 4 * tid);
        const int s4 = c.x + c.y + c.z + c.w; int inc = s4;
#pragma unroll
        for (int o = 1; o < 64; o <<= 1) { const int t = __shfl_up(inc, o); if (tid >= o) inc += t; }
        const int ex = inc - s4;
        basel[4 * tid] = ex; basel[4 * tid + 1] = ex + c.x; basel[4 * tid + 2] = ex + c.x + c.y; basel[4 * tid + 3] = ex + c.x + c.y + c.z;
    }
    __syncthreads();
}

template <int PM>
__device__ __forceinline__ void phase2a(const Params& p, int l, LAS char* lds) {
    const int tid = threadIdx.x;
    LAS int* basel = (LAS int*)(lds + LDS_BASE);
    const int* cnt = p.cnt + l * NE;
    const unsigned xb0 = *(volatile LAS unsigned*)(lds + LDS_XB), xb1 = *(volatile LAS unsigned*)(lds + LDS_XB + 4);
    expert_bases(cnt, basel, tid);
    if (gridDim.x == 256) {
        LAS int* sorted = (LAS int*)(lds + LDS_MISC);
        {
            const int lane = tid & 63, wv = tid >> 6;
            int cst[4];
#pragma unroll
            for (int jj = 0; jj < 4; ++jj) { const int c = cnt[lane + 64 * jj]; cst[jj] = c + (c > 128 * EMT ? 224 : 0); }
            for (int i = 0; i < 32; ++i) {
                const int e = wv * 32 + i;
                const int ce0 = cnt[e]; const int ce = ce0 + (ce0 > 128 * EMT ? 224 : 0);
                int rk = 0;
#pragma unroll
                for (int jj = 0; jj < 4; ++jj) { const int id = lane + 64 * jj; rk += __popcll(__ballot(cst[jj] > ce || (cst[jj] == ce && id < e))); }
                if (lane == 0) sorted[rk] = e;
            }
        }
        __syncthreads();
        const int x = blockIdx.x & 7, rank = blockIdx.x >> 3, j = rank & 3, g = x + 8 * (rank >> 2);
        int ue[4], ub[4];
#pragma unroll
        for (int rd = 0; rd < 4; ++rd) { ue[rd] = __builtin_amdgcn_readfirstlane(sorted[rd * 64 + ((rd & 1) ? 63 - g : g)]); ub[rd] = __builtin_amdgcn_readfirstlane(basel[ue[rd]]); }
        __syncthreads();
#pragma unroll 1
        for (int rd = 0; rd < 4; ++rd) { const int e = rd == 0 ? ue[0] : rd == 1 ? ue[1] : rd == 2 ? ue[2] : ue[3], bs = rd == 0 ? ub[0] : rd == 1 ? ub[1] : rd == 2 ? ub[2] : ub[3];
            gemm1_unit<PM>(p, l, e, cnt[e], bs, j, lds, tid); }
    } else {
        for (int u = blockIdx.x; u < NE * 4; u += gridDim.x) {
            const int e = u >> 2, j = u & 3;
            expert_bases(cnt, basel, tid); const int bs = __builtin_amdgcn_readfirstlane(basel[e]); __syncthreads();
            gemm1_unit<PM>(p, l, e, cnt[e], bs, j, lds, tid);
            __syncthreads();
        }
    }
    __syncthreads();
    if (tid == 0) { *(volatile LAS unsigned*)(lds + LDS_XB) = xb0; *(volatile LAS unsigned*)(lds + LDS_XB + 4) = xb1; }
    __syncthreads();
}

constexpr int P2B_RS = 128, P2B_BUF = 256 * P2B_RS;
__device__ __forceinline__ int p2b_g(int k) { return ((k >> 1) & 1) | (((k >> 3) & 1) << 1); }
template <int PM, int TPW>
__device__ __forceinline__ void gemm2_block(const Params& p, int l, int e, int base, int row0, int rows, LAS char* lds, int tid_in) {
    const int tid = launder(tid_in), wid = __builtin_amdgcn_readfirstlane(tid >> 6), lane = tid & 63, r = lane & 15, q = lane >> 4;
    const float* w2 = p.w_down + ((size_t)l * NE + e) * FE * D;
    const int* ltok = p.ltok + (size_t)e * LCAP + row0;
    const int T = (rows + 15) >> 4;
    const bool active = (TPW * wid) < T;
    bf16x8 hf[TPW][8];
    {
#pragma unroll
        for (int mt = 0; mt < TPW; ++mt) {
            int row = (TPW * wid + mt) * 16 + r; if (row >= rows) row = 0;
            const bf16_t* hp = p.Hb + (size_t)(base + row0 + row) * FE + 8 * q;
#pragma unroll
            for (int ks = 0; ks < 8; ++ks) hf[mt][ks] = *(const bf16x8*)(hp + ks * 32);
        }
    }
    const int n4 = tid & 15, kq = tid >> 4;
    const float* wsrc = w2 + (size_t)kq * D + 4 * n4;
    LAS char* wdst = lds + kq * P2B_RS + (((n4 >> 2) ^ p2b_g(kq)) << 5) + (n4 & 3) * 8;
    const int rrow = 8 * q + (r >> 2);
    const LAS char* rbase = lds + rrow * P2B_RS + (r & 3) * 8; const int rg = p2b_g(rrow);
    int yslot[2 * TPW];
#pragma unroll
    for (int rr = 0; rr < 2 * TPW; ++rr) { const int row = TPW * wid * 16 + rr * 8 + (lane >> 3); yslot[rr] = ltok[row < rows ? row : 0]; }
    f32x4 wr[8];
    if (PM == 3 || PM == 4) { for (int i = 0; i < 8; ++i) wr[i] = (f32x4){1.f, 2.f, 3.f, 4.f}; }
    const unsigned wvoff = (unsigned)((kq * D + 4 * n4) * 4);
#define W2_LOAD1(c, i) if (PM != 3 && PM != 4) { const char* b_ = (const char*)w2 + ((size_t)(32 * (i)) * D + (size_t)(c) * 64) * 4; \
        asm volatile("global_load_dwordx4 %0, %1, %2" : "=&v"(wr[i]) : "v"(wvoff), "s"(b_) : "memory"); }
#define W2_STORE1(bufoff, i) if (PM != 4) { u32x2 o; o.x = cvtpk(wr[i][0], wr[i][1]); o.y = cvtpk(wr[i][2], wr[i][3]); *(LAS u32x2*)(wdst + (bufoff) + 32 * (i) * P2B_RS) = o; }
#define W2_WAIT() asm volatile("s_waitcnt vmcnt(0)" : "+v"(wr[0]), "+v"(wr[1]), "+v"(wr[2]), "+v"(wr[3]), "+v"(wr[4]), "+v"(wr[5]), "+v"(wr[6]), "+v"(wr[7]) :: "memory")
#pragma unroll
    for (int i = 0; i < 8; ++i) W2_LOAD1(0, i);
    W2_WAIT();
#pragma unroll
    for (int i = 0; i < 8; ++i) W2_STORE1(0, i);
#pragma unroll
    for (int i = 0; i < 8; ++i) W2_LOAD1(1, i);
    LDS_BARRIER();
    __builtin_amdgcn_sched_barrier(0);
#pragma unroll 1
    for (int c = 0; c < 16; ++c) {
        const int cur = (c & 1) * P2B_BUF, nxt = P2B_BUF - cur;
        const int cn = c + 2 < 16 ? c + 2 : 15;
        W2_WAIT();
        __builtin_amdgcn_sched_barrier(0);
        if (!active) {
#pragma unroll
            for (int i = 0; i < 8; ++i) W2_STORE1(nxt, i);
#pragma unroll
            for (int i = 0; i < 8; ++i) W2_LOAD1(cn, i);
        }
        if (active) {
            const LAS char* rb3 = (const LAS char*)(size_t)(unsigned)launder((int)(size_t)(rbase + (rg << 5)));
            f32x4 acc[4][TPW];
#pragma unroll
            for (int nt = 0; nt < 4; ++nt)
#pragma unroll
                for (int mt = 0; mt < TPW; ++mt) acc[nt][mt] = (f32x4){0.f, 0.f, 0.f, 0.f};
#pragma unroll
            for (int g = 0; g < 32; ++g) {
                const int ks = g >> 2, nt = g & 3;
                const LAS char* bp = (const LAS char*)((unsigned)(size_t)rb3 ^ (nt << 5)) + cur + ks * 32 * P2B_RS;
                bf16x8 bf;
                if (PM != 5) {
                    const s16x4 lo = __builtin_bit_cast(s16x4, __builtin_amdgcn_ds_read_tr16_b64_v4i16((LAS s16x4*)bp));
                    const s16x4 hi = __builtin_bit_cast(s16x4, __builtin_amdgcn_ds_read_tr16_b64_v4i16((LAS s16x4*)(bp + 4 * P2B_RS)));
                    bf = (bf16x8){lo[0], lo[1], lo[2], lo[3], hi[0], hi[1], hi[2], hi[3]};
                } else bf = hf[0][(ks + nt) & 7];
                if (PM != 2) {
#pragma unroll
                    for (int mt = 0; mt < TPW; ++mt) acc[nt][mt] = mfma16(bf, hf[mt][ks], acc[nt][mt]);
                } else asm volatile("" :: "v"(bf));
                if (g < 8) { W2_STORE1(nxt, g); } else if (g < 16) { W2_LOAD1(cn, g - 8); }
                if ((g & 1) == 1) __builtin_amdgcn_sched_barrier(0);
            }
            {
                LAS char* stg = lds + 2 * P2B_BUF + wid * (2048 * TPW);
#pragma unroll
                for (int mt = 0; mt < TPW; ++mt)
#pragma unroll
                    for (int nt = 0; nt < 4; ++nt) {
                        int w = __builtin_amdgcn_cvt_pk_fp8_f32(acc[nt][mt][0] * YSCALE, acc[nt][mt][1] * YSCALE, 0, false);
                        w = __builtin_amdgcn_cvt_pk_fp8_f32(acc[nt][mt][2] * YSCALE, acc[nt][mt][3] * YSCALE, w, true);
                        *(LAS int*)(stg + (mt * 16 + r) * 128 + ((((c & 1) * 4 + nt) ^ (r & 7)) << 4) + q * 4) = w;
                    }
                if (c & 1) {
                    asm volatile("s_waitcnt lgkmcnt(0)" ::: "memory");
#pragma unroll
                    for (int rr = 0; rr < 2 * TPW; ++rr) {
                        const int srow = rr * 8 + (lane >> 3), row = TPW * wid * 16 + srow;
                        const u32x4 v = *(const LAS u32x4*)(stg + srow * 128 + (((lane & 7) ^ (srow & 7)) << 4));
                        if (PM != 6 && row < rows) *(u32x4*)((PM ? (unsigned char*)p.Ob + (size_t)((base + row0 + row) & 1023) * D : p.Y8 + (size_t)yslot[rr] * D) + (c >> 1) * 128 + (lane & 7) * 16) = v;
                    }
                }
            }
        }
        __builtin_amdgcn_sched_barrier(0);
        LDS_BARRIER();
    }
#undef W2_LOAD1
#undef W2_STORE1
#undef W2_WAIT
}
template <int PM>
__device__ __forceinline__ void phase2b(const Params& p, int l, LAS char* lds) {
    const int tid = threadIdx.x;
    LAS int* basel = (LAS int*)(lds + LDS_BASE);
    LAS int* ubl = (LAS int*)(lds + LDS_MISC);
    const int* cnt = p.cnt + l * NE;
    expert_bases(cnt, basel, tid);
    if (tid < 64) {
        const int4 c = *(const int4*)(cnt + 4 * launder(tid));
        const int u0 = (c.x + 383) / 384, u1 = (c.y + 383) / 384, u2 = (c.z + 383) / 384, u3 = (c.w + 383) / 384;
        const int s4 = u0 + u1 + u2 + u3; int inc = s4;
#pragma unroll
        for (int o = 1; o < 64; o <<= 1) { const int t = __shfl_up(inc, o); if (tid >= o) inc += t; }
        const int ex = inc - s4;
        ubl[4 * tid] = ex; ubl[4 * tid + 1] = ex + u0; ubl[4 * tid + 2] = ex + u0 + u1; ubl[4 * tid + 3] = ex + u0 + u1 + u2;
        if (tid == 63) ubl[256] = inc;
    }
    __syncthreads();
    const int nunits = ubl[256];
    const int vc = (gridDim.x == 256) ? ((blockIdx.x & 7) * 32 + (blockIdx.x >> 3)) : blockIdx.x;
    for (int u = vc; u < nunits; u += gridDim.x) {
        int lo = 0, hi = NE - 1;
        while (lo < hi) { const int mid = (lo + hi + 1) >> 1; if (ubl[mid] <= u) lo = mid; else hi = mid - 1; }
        const int e = lo, c = cnt[e], nblk = (c + 383) / 384, k = u - ubl[e];
        const int rpb = ((((c + nblk - 1) / nblk) + 15) >> 4) << 4;
        const int row0 = k * rpb, rows = (c - row0 < rpb) ? (c - row0) : rpb;
        if (rows > 0) {
            const int tpw = (((rows + 15) >> 4) + 7) >> 3;
            const int bs = basel[e];
            if (tpw == 1) gemm2_block<PM, 1>(p, l, e, bs, row0, rows, lds, tid);
            else if (tpw == 2) gemm2_block<PM, 2>(p, l, e, bs, row0, rows, lds, tid);
            else gemm2_block<PM, 3>(p, l, e, bs, row0, rows, lds, tid);
        }
        __syncthreads();
    }
}

template <bool FINAL>
__device__ __forceinline__ void phase3(const Params& p, int l, LAS char* lds) {
    LAS char* panel = lds + LDS_PANEL; LAS float* red = (LAS float*)(lds + LDS_RED); LAS int* basel = (LAS int*)(lds + LDS_BASE);
    const bf16_t* xin = l ? p.x3 : p.x1;
    expert_bases(p.cnt + l * NE, basel, threadIdx.x);
    for (int tile = blockIdx.x; tile < NTILE; tile += gridDim.x) {
        const int tid = launder(threadIdx.x), wid = __builtin_amdgcn_readfirstlane(tid >> 6), lane = tid & 63, r = lane & 15, q = lane >> 4;
        const int t0 = tile * 64;
        load_panel(xin + (size_t)t0 * D, panel, tid);
#pragma unroll 1
        for (int i = 0; i < 8; i += 2) {
            u32x4 xv[2][2], yv[2][TOPK];
#pragma unroll
            for (int u = 0; u < 2; ++u) {
                const int t = t0 + wid * 8 + i + u;
                xv[u][0] = *(const u32x4*)(xin + (size_t)t * D + lane * 16); xv[u][1] = *(const u32x4*)(xin + (size_t)t * D + lane * 16 + 8);
#pragma unroll
                for (int k = 0; k < TOPK; ++k) yv[u][k] = *(const u32x4*)(p.Y8 + (size_t)(t * TOPK + k) * D + lane * 16);
            }
#pragma unroll
            for (int u = 0; u < 2; ++u) {
                const int t = t0 + wid * 8 + i + u;
#pragma unroll
                for (int h = 0; h < 2; ++h) {
                    u32x4 o;
#pragma unroll
                    for (int c2 = 0; c2 < 2; ++c2) {
                        const int c = 2 * h + c2;
                        float s0 = 0.f, s1 = 0.f, s2 = 0.f, s3 = 0.f;
#pragma unroll
                        for (int k = 0; k < TOPK; ++k) {
                            const f32x2_t lo = __builtin_amdgcn_cvt_pk_f32_fp8((int)yv[u][k][c], false), hi = __builtin_amdgcn_cvt_pk_f32_fp8((int)yv[u][k][c], true);
                            s0 += lo[0]; s1 += lo[1]; s2 += hi[0]; s3 += hi[1];
                        }
                        const unsigned x01 = xv[u][h][2 * c2], x23 = xv[u][h][2 * c2 + 1];
                        o[2 * c2] = cvtpk(fmaf(s0, 1.0f / YSCALE, ALPHA * bf_lo(x01)), fmaf(s1, 1.0f / YSCALE, ALPHA * bf_hi(x01)));
                        o[2 * c2 + 1] = cvtpk(fmaf(s2, 1.0f / YSCALE, ALPHA * bf_lo(x23)), fmaf(s3, 1.0f / YSCALE, ALPHA * bf_hi(x23)));
                    }
                    *(u32x4*)(p.x2 + (size_t)t * D + lane * 16 + h * 8) = o;
                }
            }
        }
        __syncthreads();
        f32x4 ua[4][4];
#pragma unroll
        for (int nt = 0; nt < 4; ++nt)
#pragma unroll
            for (int mt = 0; mt < 4; ++mt) ua[nt][mt] = (f32x4){0.f, 0.f, 0.f, 0.f};
        panel_mma<2, 0, 4>(ua, panel, 2048, 0, 32, p.wt_wsgu + (size_t)l * D * 512, (2 * wid) * 32 * 512, 32 * 512, lane);
        panel_mma<2, 2, 4>(ua, panel, 2048, 0, 32, p.wt_wsgu + (size_t)l * D * 512, (16 + 2 * wid) * 32 * 512, 32 * 512, lane);
        __syncthreads();
#pragma unroll
        for (int nt = 0; nt < 2; ++nt)
#pragma unroll
            for (int mt = 0; mt < 4; ++mt) {
                const f32x4 g = ua[nt][mt], u = ua[nt + 2][mt];
                u32x2 o; o.x = cvtpk(siluf_(g[0]) * u[0], siluf_(g[1]) * u[1]); o.y = cvtpk(siluf_(g[2]) * u[2], siluf_(g[3]) * u[3]);
                const int m = mt * 16 + r, n = 32 * wid + nt * 16 + 4 * q;
                *(LAS u32x2*)(panel + m * 512 + (((n >> 3) ^ r) << 4) + (n & 7) * 2) = o;
            }
        __syncthreads();
        f32x4 acc[8][4];
#pragma unroll
        for (int nt = 0; nt < 8; ++nt)
#pragma unroll
            for (int mt = 0; mt < 4; ++mt) acc[nt][mt] = (f32x4){0.f, 0.f, 0.f, 0.f};
        panel_mma<4, 0, 8>(acc, panel, 512, 0, 8, p.wt_wsd + (size_t)l * FE * D, (8 * wid) * 8 * 512, 8 * 512, lane);
        panel_mma<4, 4, 8>(acc, panel, 512, 0, 8, p.wt_wsd + (size_t)l * FE * D, (8 * wid + 4) * 8 * 512, 8 * 512, lane);
        const int colbase = 128 * wid;
        __syncthreads();
        load_panel(p.x2 + (size_t)t0 * D, panel, tid);
        __syncthreads();
#pragma unroll
        for (int mt = 0; mt < 4; ++mt) {
#pragma unroll
            for (int nt = 0; nt < 8; ++nt) {
                const int n = colbase + nt * 16 + 4 * q;
                const u32x2 cv = *(const LAS u32x2*)(panel + (mt * 16 + r) * 2048 + (((n >> 3) ^ r) << 4) + (n & 7) * 2);
                acc[nt][mt][0] += bf_lo(cv.x); acc[nt][mt][1] += bf_hi(cv.x); acc[nt][mt][2] += bf_lo(cv.y); acc[nt][mt][3] += bf_hi(cv.y);
            }
#pragma unroll
            for (int nt = 0; nt < 8; ++nt) VPIN(acc[nt][mt]);
            CFENCE();
        }
        float mean[4], rstd[4];
        ln_stats<8>(acc, red, wid, lane, mean, rstd);
        const float* lg = p.ln_g + (l * 2 + 1) * D; const float* lb = p.ln_b + (l * 2 + 1) * D;
#pragma unroll
        for (int nt = 0; nt < 8; ++nt) {
            const int n = colbase + nt * 16 + 4 * q;
            const float4 g4 = *(const float4*)(lg + n), b4 = *(const float4*)(lb + n);
#pragma unroll
            for (int mt = 0; mt < 4; ++mt) {
                const int m = mt * 16 + r;
                const float y0 = (acc[nt][mt][0] - mean[mt]) * rstd[mt] * g4.x + b4.x, y1 = (acc[nt][mt][1] - mean[mt]) * rstd[mt] * g4.y + b4.y;
                const float y2 = (acc[nt][mt][2] - mean[mt]) * rstd[mt] * g4.z + b4.z, y3 = (acc[nt][mt][3] - mean[mt]) * rstd[mt] * g4.w + b4.w;
                if (FINAL) { *(float4*)(p.out + (size_t)(t0 + m) * D + n) = make_float4(y0, y1, y2, y3); }
                else {
                    u32x2 o; o.x = cvtpk(y0, y1); o.y = cvtpk(y2, y3);
                    *(LAS u32x2*)(panel + m * 2048 + (((n >> 3) ^ r) << 4) + (n & 7) * 2) = o;
                }
            }
            CFENCE();
        }
        __syncthreads();
        if (!FINAL) {
            store_panel(p.x2 + (size_t)t0 * D, panel, tid);
#pragma unroll 1
            for (int ps = 0; ps < 3; ++ps) {
                const int lane = launder(tid) & 63, r = lane & 15, q = lane >> 4;
#pragma unroll
                for (int nt = 0; nt < 8; ++nt)
#pragma unroll
                    for (int mt = 0; mt < 4; ++mt) acc[nt][mt] = (f32x4){0.f, 0.f, 0.f, 0.f};
                const bf16_t* wt = (ps < 2) ? p.wt_kvf : p.wt_q;
                const int tb = (ps == 1 ? 64 : 0) + 8 * wid;
                panel_mma<4, 0, 8>(acc, panel, 2048, 0, 32, wt, tb * 32 * 512, 32 * 512, lane);
                panel_mma<4, 4, 8>(acc, panel, 2048, 0, 32, wt, (tb + 4) * 32 * 512, 32 * 512, lane);
                bf16_t* dst = (ps == 0) ? p.Kb : (ps == 1) ? p.Vb : p.Qb;
                const float sc = (ps == 2) ? C2 : 1.0f;
                {
                    LAS char* stg = lds + LDS_STAGE + wid * 2048;
                    float mx0 = 0.f, mx1 = 0.f;
#pragma unroll
                    for (int mt = 0; mt < 4; ++mt) {
                        const int ln = launder(tid) & 63, r2 = ln & 15, q2 = ln >> 4;
                        bf16_t* drow = dst + (size_t)(t0 + mt * 16 + (ln >> 3)) * D + 128 * wid + (ln & 7) * 8;
#pragma unroll
                        for (int hh = 0; hh < 2; ++hh) {
#pragma unroll
                            for (int n2 = 0; n2 < 4; ++n2) {
                                const int nt = hh * 4 + n2;
                                u32x2 o; o.x = cvtpk(acc[nt][mt][0] * sc, acc[nt][mt][1] * sc); o.y = cvtpk(acc[nt][mt][2] * sc, acc[nt][mt][3] * sc);
                                *(LAS u32x2*)(stg + r2 * 128 + (((2 * n2 + (q2 >> 1)) ^ (r2 & 7)) << 4) + (q2 & 1) * 8) = o;
                            }
                            asm volatile("s_waitcnt lgkmcnt(0)" ::: "memory");
#pragma unroll
                            for (int i = 0; i < 2; ++i) {
                                const int srow = i * 8 + (ln >> 3);
                                const u32x4 v = *(const LAS u32x4*)(stg + srow * 128 + (((ln & 7) ^ (srow & 7)) << 4));
                                *(u32x4*)(drow + (size_t)(i * 8) * D + hh * 64) = v;
                                if (ps != 1) {
                                    float ss = 0.f;
#pragma unroll
                                    for (int c = 0; c < 4; ++c) { const float a = bf_lo(v[c]), b2 = bf_hi(v[c]); ss = fmaf(a, a, ss); ss = fmaf(b2, b2, ss); }
                                    ss += __shfl_xor(ss, 1); ss += __shfl_xor(ss, 2); ss += __shfl_xor(ss, 4);
                                    if (hh == 0) mx0 = fmaxf(mx0, ss); else mx1 = fmaxf(mx1, ss);
                                }
                            }
                            asm volatile("s_waitcnt lgkmcnt(0)" ::: "memory");
                        }
                    }
                    if (ps != 1) {
                        mx0 = fmaxf(mx0, __shfl_xor(mx0, 8)); mx0 = fmaxf(mx0, __shfl_xor(mx0, 16)); mx0 = fmaxf(mx0, __shfl_xor(mx0, 32));
                        mx1 = fmaxf(mx1, __shfl_xor(mx1, 8)); mx1 = fmaxf(mx1, __shfl_xor(mx1, 16)); mx1 = fmaxf(mx1, __shfl_xor(mx1, 32));
                        if ((tid & 63) == 0) {
                            const int b = t0 / S;
                            if (ps == 0) { atomicMax(p.kmax2 + b * NH + 2 * wid, __float_as_uint(mx0)); atomicMax(p.kmax2 + b * NH + 2 * wid + 1, __float_as_uint(mx1)); }
                            else { atomicMax(p.qmax2 + (b * NH + 2 * wid) * 16 + ((t0 % S) >> 8), __float_as_uint(mx0)); atomicMax(p.qmax2 + (b * NH + 2 * wid + 1) * 16 + ((t0 % S) >> 8), __float_as_uint(mx1)); }
                        }
                    }
                }
            }
            LAS float* lfs = (LAS float*)(lds + LDS_MISC);
            if (wid == 0) {
                f32x4 fa[1][4];
#pragma unroll
                for (int mt = 0; mt < 4; ++mt) fa[0][mt] = (f32x4){0.f, 0.f, 0.f, 0.f};
                panel_mma<1, 0, 1>(fa, panel, 2048, 0, 32, p.wt_kvf, 128 * 32 * 512, 0, lane);
                const float4 bf4 = *(const float4*)(p.b_f + 4 * q);
#pragma unroll
                for (int mt = 0; mt < 4; ++mt) {
                    f32x4 z = fa[0][mt]; z[0] += bf4.x; z[1] += bf4.y; z[2] += bf4.z; z[3] += bf4.w;
                    f32x4 o;
#pragma unroll
                    for (int i = 0; i < 4; ++i) o[i] = fminf(z[i], 0.f) - log1pf(__expf(-fabsf(z[i])));
                    *(LAS f32x4*)(lfs + (mt * 16 + r) * 16 + 4 * q) = o;
                }
            }
            __syncthreads();
            if (tid < 16) {
                const int b = t0 / S, s0 = t0 % S; float run = 0.f;
                float* fo = p.Floc + (size_t)(b * NH + tid) * S + s0;
                for (int m = 0; m < 64; ++m) { run += lfs[m * 16 + tid]; fo[m] = run; }
                p.Tsum[(b * NH + tid) * 64 + (s0 >> 6)] = run;
            }
            __syncthreads();
        }
    }
}
namespace attn_body {
using bf16=__hip_bfloat16;
using bf16x8=__attribute__((ext_vector_type(8)))short;
using s16x4=__attribute__((ext_vector_type(4)))short;
using f32x16=__attribute__((ext_vector_type(16)))float;
using u32x4=__attribute__((ext_vector_type(4)))unsigned;
using f32x4v=__attribute__((ext_vector_type(4)))float;
constexpr int BATCH=4,NHEAD=16,SEQ=4096,D=64,DM=NHEAD*D;
constexpr int NW=8,QBLK=32,QB=QBLK*NW,KVBLK=64,NQB=SEQ/QB;
constexpr int ATTN_PITCH=DM, ATTN_UNIT_ROWS=QB;
__device__ __forceinline__ int crow(int r,int hi){return (r&3)+8*(r>>2)+4*hi;}
#define SBAR() __builtin_amdgcn_sched_barrier(0)
__device__ __forceinline__ void cmask(f32x16&p0,f32x16&p1,int jb,int qrel,int hi){
  const float NEG=-INFINITY; int kb=64*jb+4*hi;
  #pragma unroll
  for(int r=0;r<16;++r){int kv=kb+(r&3)+8*(r>>2); if(kv>qrel)p0[r]=NEG; if(kv+32>qrel)p1[r]=NEG;}
}

constexpr int NSLOT=3, SLOTB=8192;
constexpr int LDS_K=0, LDS_V=NSLOT*SLOTB, LDS_WS=2*NSLOT*SLOTB, LDS_OST=LDS_WS+NW*64*4, LDS_G=LDS_OST+NW*4096, LDS_BYTES=LDS_G+SEQ*4;
constexpr float C2=0.125f*1.4426950408889634f;
__device__ __forceinline__ void glds16(const void*gsrc,unsigned lds_dst){unsigned keep;
  asm volatile("s_mov_b32 %0, m0\n\ts_mov_b32 m0, %2\n\ts_nop 0\n\tglobal_load_lds_dwordx4 %1, off\n\ts_mov_b32 m0, %0":"=&s"(keep):"v"(gsrc),"s"(lds_dst):"memory");}
__device__ __forceinline__ float max3f(float a,float b,float c){float r;asm("v_max3_f32 %0, %1, %2, %3":"=v"(r):"v"(a),"v"(b),"v"(c));return r;}
__device__ __forceinline__ float max2f(float a,float b){float r;asm("v_max_f32_e32 %0, %1, %2":"=v"(r):"v"(a),"v"(b));return r;}
__device__ __forceinline__ float fadd_s(float a,float b){float r;asm("v_add_f32_e32 %0, %1, %2":"=v"(r):"v"(a),"v"(b));return r;}
__device__ __forceinline__ float fsub_s(float a,float b){float r;asm("v_sub_f32_e32 %0, %1, %2":"=v"(r):"v"(a),"v"(b));return r;}
typedef float f32x2_t __attribute__((ext_vector_type(2))); typedef __bf16 bf16x2_t __attribute__((ext_vector_type(2)));
__device__ __forceinline__ unsigned cvtpk_s(float lo,float hi){f32x2_t v={lo,hi};bf16x2_t b=__builtin_convertvector(v,bf16x2_t);return __builtin_bit_cast(unsigned,b);}
#define WAIT_BAR(N) asm volatile("s_waitcnt vmcnt(" #N ") lgkmcnt(0)\n\ts_barrier":::"memory")

__device__ __forceinline__ void qkt(f32x16&p0,f32x16&p1,const char*Kslot,const bf16x8*qr,int r32,int hi){
  const char*kb=Kslot+hi*1024+r32*16;
  #pragma unroll
  for(int d0=0;d0<4;++d0){
    const bf16x8 b0=*reinterpret_cast<const bf16x8*>(kb+d0*2048);
    const bf16x8 b1=*reinterpret_cast<const bf16x8*>(kb+d0*2048+512);
    p0=__builtin_amdgcn_mfma_f32_32x32x16_bf16(b0,qr[d0],p0,0,0,0);p1=__builtin_amdgcn_mfma_f32_32x32x16_bf16(b1,qr[d0],p1,0,0,0);}
}
typedef __attribute__((address_space(3))) const char* lds_cptr;
typedef short v4i16_t __attribute__((ext_vector_type(4)));
__device__ __forceinline__ void kload8(bf16x8*kf,lds_cptr kp){
  kf[0]=*(const __attribute__((address_space(3))) bf16x8*)(kp);      kf[1]=*(const __attribute__((address_space(3))) bf16x8*)(kp+512);
  kf[2]=*(const __attribute__((address_space(3))) bf16x8*)(kp+2048); kf[3]=*(const __attribute__((address_space(3))) bf16x8*)(kp+2560);
  kf[4]=*(const __attribute__((address_space(3))) bf16x8*)(kp+4096); kf[5]=*(const __attribute__((address_space(3))) bf16x8*)(kp+4608);
  kf[6]=*(const __attribute__((address_space(3))) bf16x8*)(kp+6144); kf[7]=*(const __attribute__((address_space(3))) bf16x8*)(kp+6656);
}
__device__ __forceinline__ void kload2(bf16x8*kf,lds_cptr kp,int j){ kf[2*j]=*(const __attribute__((address_space(3))) bf16x8*)(kp+j*2048); kf[2*j+1]=*(const __attribute__((address_space(3))) bf16x8*)(kp+j*2048+512); }
__device__ __forceinline__ s16x4 vtr(lds_cptr p){ return __builtin_bit_cast(s16x4,__builtin_amdgcn_ds_read_tr16_b64_v4i16((__attribute__((address_space(3))) v4i16_t*)p)); }
__device__ __forceinline__ float rowmax(const f32x16&p0,const f32x16&p1){
  float a=max3f(p0[0],p0[1],p1[0]),b=max3f(p0[2],p0[3],p1[1]);a=max3f(a,p1[2],p1[3]);
  #pragma unroll
  for(int r=4;r<16;r+=4){a=max3f(a,p0[r],p0[r+1]);b=max3f(b,p0[r+2],p0[r+3]);a=max3f(a,p1[r],p1[r+1]);b=max3f(b,p1[r+2],p1[r+3]);}
  const float m=max2f(a,b);
  auto rr=__builtin_amdgcn_permlane32_swap(__float_as_uint(m),__float_as_uint(m),false,false);
  return max2f(__uint_as_float(rr[0]),__uint_as_float(rr[1]));
}
__device__ __forceinline__ void pv(f32x16*o,int vb,bf16x8 pa0,bf16x8 pa1,bf16x8 pa2,bf16x8 pa3){
  #pragma unroll
  for(int d0=0;d0<2;++d0){s16x4 lo[4],hi[4];
    #pragma unroll
    for(int ks=0;ks<4;++ks){
      asm volatile("ds_read_b64_tr_b16 %0,%1 offset:%c2":"=&v"(lo[ks]):"v"(vb),"i"(d0*4096+ks*1024):"memory");
      asm volatile("ds_read_b64_tr_b16 %0,%1 offset:%c2":"=&v"(hi[ks]):"v"(vb),"i"(d0*4096+ks*1024+512):"memory");}
    asm volatile("s_waitcnt lgkmcnt(0)":::"memory");SBAR();
    #define PK(k) (bf16x8){lo[k][0],lo[k][1],lo[k][2],lo[k][3],hi[k][0],hi[k][1],hi[k][2],hi[k][3]}
    o[d0]=__builtin_amdgcn_mfma_f32_32x32x16_bf16(pa0,PK(0),o[d0],0,0,0);
    o[d0]=__builtin_amdgcn_mfma_f32_32x32x16_bf16(pa1,PK(1),o[d0],0,0,0);
    o[d0]=__builtin_amdgcn_mfma_f32_32x32x16_bf16(pa2,PK(2),o[d0],0,0,0);
    o[d0]=__builtin_amdgcn_mfma_f32_32x32x16_bf16(pa3,PK(3),o[d0],0,0,0);
    #undef PK
  }
}

#ifndef ATTN_STORE16
#define ATTN_STORE16(p,v) (*(u32x4*)(p)=(v))
#endif
template<int THRL> __device__ __forceinline__ void attn_unit(int b,int h,int qb,const bf16*Q,const bf16*__restrict__ K,const bf16*__restrict__ V,bf16*O,const float*__restrict__ Floc,const float*__restrict__ Tsum,const unsigned*__restrict__ kmax2,const unsigned*__restrict__ qmax2,char*shm){
  const int tid=launder((int)threadIdx.x),lane=tid&63,r32=lane&31,hi=lane>>5; const int wid=__builtin_amdgcn_readfirstlane(tid>>6);
  const long rowbase=(long)b*SEQ; const int q0=qb*QB;
  typedef __attribute__((address_space(3))) float* lds_fptr; typedef __attribute__((address_space(3))) const f32x4v* lds_f4ptr;
  const lds_fptr Gs=(lds_fptr)((__attribute__((address_space(3))) char*)shm+LDS_G);
  { float tv=Tsum[(b*NHEAD+h)*64+lane]; float inc=tv;
    #pragma unroll
    for(int o=1;o<64;o<<=1){const float t_=__shfl_up(inc,o); if(lane>=o)inc+=t_;}
    const float ex=inc-tv; const float*fl=Floc+(long)(b*NHEAD+h)*SEQ;
    for(int j0=0;j0<q0+QB;j0+=NW*64){ const int j=j0+tid; const float off=__shfl(ex,(j>>6)&63); if(j<q0+QB)Gs[j]=(fl[j]+off)*1.4426950408889634f; }
    __syncthreads(); }
  int t0s=0;
  { const float qk=sqrtf(__uint_as_float(qmax2[(b*NHEAD+h)*16+qb]))*sqrtf(__uint_as_float(kmax2[b*NHEAD+h]))*1.02f+1.0f;
    const float thr=-150.f-qk-Gs[q0];
    int lo=0,hi=(q0+QB)/KVBLK-4;
    while(lo<hi){ const int mid=(lo+hi)>>1; if(-Gs[64*mid+63]>=thr)hi=mid; else lo=mid+1; }
    t0s=lo&~1; }
  const bf16*Qw=Q+(rowbase+q0+wid*QBLK)*DM+h*D;
  const bf16*Kh=K+(rowbase+(long)t0s*KVBLK)*DM+h*D,*Vh=V+(rowbase+(long)t0s*KVBLK)*DM+h*D;
  const lds_fptr Gst=Gs+64*t0s;
  const unsigned lds0=(unsigned)(uintptr_t)shm;
  float*wsf=(float*)(shm+LDS_WS)+wid*64;
  const bf16*ksrc=Kh+(long)lane*DM+wid*8;
  const bf16*vsrc=Vh+(long)(16*(wid&3)+(lane>>2))*DM+(wid>>2)*32+(lane&3)*8;
  const unsigned kdst=lds0+LDS_K+wid*1024, vdst=lds0+LDS_V+wid*1024;
  #define DMA_K(t,slot) glds16(ksrc+(long)(t)*KVBLK*DM,(unsigned)__builtin_amdgcn_readfirstlane(kdst+(slot)))
  #define DMA_V(t,slot) glds16(vsrc+(long)(t)*KVBLK*DM,(unsigned)__builtin_amdgcn_readfirstlane(vdst+(slot)))
  const int vb0=(int)(lds0+LDS_V)+((lane>>4)&1)*32+(lane&3)*8+(4*hi+((lane&15)>>2))*64;
  const char*Kbase=shm+LDS_K; bf16x8 kf[8];
  const lds_cptr shm3=(lds_cptr)shm; const lds_cptr kp0=shm3+LDS_K+hi*1024+r32*16; const lds_cptr vp0=shm3+LDS_V+((lane>>4)&1)*32+(lane&3)*8+(4*hi+((lane&15)>>2))*64;
  const int NT=(q0+QB)/KVBLK-t0s;
  DMA_K(0,0);DMA_V(0,0);DMA_K(1,SLOTB);
  bf16x8 qr[4];
  #pragma unroll
  for(int d0=0;d0<4;++d0)qr[d0]=*reinterpret_cast<const bf16x8*>(&Qw[(long)r32*DM+d0*16+hi*8]);
  const int qrel=wid*QBLK+r32;
  const float gi=Gs[q0+qrel];
  float mhat=0.f,l_reg=0.f;f32x16 o[2];o[0]=f32x16{};o[1]=f32x16{};float cinit=gi;
  #define BINIT(P0,P1,t) do{ const lds_f4ptr gp_=(lds_f4ptr)(Gst+64*(t)+4*hi); \
    _Pragma("unroll") for(int g_=0;g_<4;++g_){ const f32x4v a_=gp_[2*g_]; \
      _Pragma("unroll") for(int i_=0;i_<4;++i_) P0[4*g_+i_]=a_[i_]; } \
    _Pragma("unroll") for(int g_=0;g_<4;++g_){ const f32x4v b_=gp_[2*g_+8]; \
      _Pragma("unroll") for(int i_=0;i_<4;++i_) P1[4*g_+i_]=b_[i_]; } \
    _Pragma("unroll") for(int r_=0;r_<16;++r_){ P0[r_]=cinit-P0[r_]; P1[r_]=cinit-P1[r_]; } }while(0)
  #define CMASK(P0,P1,t) do{int jb_=(t)-(NT-4); if(jb_>=0)cmask(P0,P1,jb_,qrel,hi);}while(0)
  bool resc=false;
  #define START(P0,P1) do{ const float rm=rowmax(P0,P1); resc=false; \
    { const float dl=__builtin_fmaxf(rm,0.f); mhat=fadd_s(mhat,dl); \
      _Pragma("unroll") for(int r=0;r<16;++r){P0[r]=fsub_s(P0[r],dl);P1[r]=fsub_s(P1[r],dl);} \
      cinit=gi-mhat; } \
    _Pragma("unroll") for(int r=0;r<16;++r)P0[r]=__builtin_amdgcn_exp2f(P0[r]); }while(0)
  #define RESC() do{ if(resc){ asm volatile("s_waitcnt lgkmcnt(0)":::"memory"); \
      _Pragma("unroll") for(int d_=0;d_<2;++d_) _Pragma("unroll") for(int r=0;r<16;++r)o[d_][r]*=wsf[crow(r,hi)]; } }while(0)
  f32x16 pA0,pA1,pB0,pB1;
  int sl_prev=0,sl_cur=0,sl_next=SLOTB;
  #define ROT() do{sl_prev=sl_cur;sl_cur=sl_next;sl_next=(sl_next==(NSLOT-1)*SLOTB)?0:sl_next+SLOTB;}while(0)
  DMA_K(2,2*SLOTB);
  WAIT_BAR(3);
  BINIT(pA0,pA1,0); qkt(pA0,pA1,Kbase,qr,r32,hi);asm volatile("s_nop 15\n\ts_nop 7":"+v"(pA0),"+v"(pA1));CMASK(pA0,pA1,0);
  START(pA0,pA1);
  _Pragma("unroll") for(int r=0;r<16;++r)pA1[r]=__builtin_amdgcn_exp2f(pA1[r]);
  WAIT_BAR(0);
  DMA_K(3,0);DMA_V(1,SLOTB);
  ROT();
  kload8(kf,kp0+sl_cur);
  WAIT_BAR(2);
  s16x4 vlo[8],vhi[8]; u32x4 pw0,pw1,pw2,pw3;
  #define PKW(P,B) cvtpk_s(P[B],P[B+1])
  #define PAF(k) __builtin_bit_cast(bf16x8,pw##k)
  #define VFR(i) (bf16x8){vlo[i][0],vlo[i][1],vlo[i][2],vlo[i][3],vhi[i][0],vhi[i][1],vhi[i][2],vhi[i][3]}
  #define PIN(x) asm volatile("":"+v"(x))
  #define MX3(a,b,c) __builtin_fmaxf(__builtin_fmaxf((a),(b)),(c))
  #define GAPA(MF,A0,A1,A2,A3,W0,W1,PW) do{ MF; sacc+=A0; sacc+=A1; sacc+=A2; sacc+=A3; PIN(sacc); W0; W1; PIN(PW); SBAR(); }while(0)
  #define EX(v) __builtin_amdgcn_exp2f(v)
  #define GAPB(MF,X,B) do{ MF; X[B]=EX(X[B]); X[B+1]=EX(X[B+1]); X[B+2]=EX(X[B+2]); X[B+3]=EX(X[B+3]); PIN(X); SBAR(); }while(0)
  #define VRD(i) do{ vlo[i]=vtr(vp_+(((i)>>2)*4096+((i)&3)*1024)); vhi[i]=vtr(vp_+(((i)>>2)*4096+((i)&3)*1024+512)); }while(0)
  #define KRD(G,j) do{ if(G){ kload2(kf,kp0+sl_next,j); SBAR(); } }while(0)
  #define STEP(C0,C1,P0,P1,t,GK,GV,GL) do{ SBAR(); BINIT(C0,C1,t); SBAR(); \
    const lds_cptr vp_=vp0+sl_prev; \
    VRD(0); SBAR(); float sacc=(P0[0]+P0[1]); \
    GAPA(C0=__builtin_amdgcn_mfma_f32_32x32x16_bf16(kf[0],qr[0],C0,0,0,0), P0[2],P0[3],P0[4],P0[5],     pw0[0]=PKW(P0,0), pw0[1]=PKW(P0,2), pw0); \
    VRD(4); SBAR(); GAPA(C1=__builtin_amdgcn_mfma_f32_32x32x16_bf16(kf[1],qr[0],C1,0,0,0), P0[6],P0[7],P0[8],P0[9],     pw0[2]=PKW(P0,4), pw0[3]=PKW(P0,6), pw0); \
    VRD(1); SBAR(); GAPA(C0=__builtin_amdgcn_mfma_f32_32x32x16_bf16(kf[2],qr[1],C0,0,0,0),   P0[10],P0[11],P0[12],P0[13], pw1[0]=PKW(P0,8), pw1[1]=PKW(P0,10), pw1); \
    VRD(5); SBAR(); GAPA(C1=__builtin_amdgcn_mfma_f32_32x32x16_bf16(kf[3],qr[1],C1,0,0,0),   P0[14],P0[15],P1[0],P1[1],   pw1[2]=PKW(P0,12),pw1[3]=PKW(P0,14), pw1); \
    VRD(2); SBAR(); GAPA(C0=__builtin_amdgcn_mfma_f32_32x32x16_bf16(kf[4],qr[2],C0,0,0,0),   P1[2],P1[3],P1[4],P1[5],     pw2[0]=PKW(P1,0), pw2[1]=PKW(P1,2), pw2); \
    VRD(6); SBAR(); GAPA(C1=__builtin_amdgcn_mfma_f32_32x32x16_bf16(kf[5],qr[2],C1,0,0,0),   P1[6],P1[7],P1[8],P1[9],     pw2[2]=PKW(P1,4), pw2[3]=PKW(P1,6), pw2); \
    VRD(3); SBAR(); GAPA(C0=__builtin_amdgcn_mfma_f32_32x32x16_bf16(kf[6],qr[3],C0,0,0,0),   P1[10],P1[11],P1[12],P1[13], pw3[0]=PKW(P1,8), pw3[1]=PKW(P1,10), pw3); \
    VRD(7); SBAR(); GAPA(C1=__builtin_amdgcn_mfma_f32_32x32x16_bf16(kf[7],qr[3],C1,0,0,0),   P1[14],P1[15],0.f,0.f,       pw3[2]=PKW(P1,12),pw3[3]=PKW(P1,14), pw3); \
    l_reg+=sacc; \
    if(GK){DMA_K((t)+3,sl_cur);} if(GV){DMA_V((t)+1,sl_next);} \
    CMASK(C0,C1,t); \
    { float a=MX3(C0[0],C0[1],C1[0]),b=MX3(C0[2],C0[3],C1[1]); a=MX3(a,C1[2],C1[3]); \
      _Pragma("unroll") for(int r=4;r<16;r+=4){a=MX3(a,C0[r],C0[r+1]);b=MX3(b,C0[r+2],C0[r+3]);a=MX3(a,C1[r],C1[r+1]);b=MX3(b,C1[r+2],C1[r+3]);} \
      float rm=__builtin_fmaxf(a,b); { auto rr=__builtin_amdgcn_permlane32_swap(__float_as_uint(rm),__float_as_uint(rm),false,false); rm=__builtin_fmaxf(__uint_as_float(rr[0]),__uint_as_float(rr[1])); } \
      resc=false; \
      if(__builtin_expect(__any(rm>(float)THRL),0)){ const float dl=__builtin_fmaxf(rm,0.f); mhat+=dl; \
        _Pragma("unroll") for(int r=0;r<16;++r){C0[r]-=dl;C1[r]-=dl;} \
        cinit=gi-mhat; \
        const float f=__builtin_amdgcn_exp2f(-dl); l_reg*=f; if(hi==0)wsf[r32]=f; resc=true; } } \
    SBAR(); \
    GAPB(o[0]=__builtin_amdgcn_mfma_f32_32x32x16_bf16(PAF(0),VFR(0),o[0],0,0,0), C0,0); \
    GAPB(o[1]=__builtin_amdgcn_mfma_f32_32x32x16_bf16(PAF(0),VFR(4),o[1],0,0,0), C0,4); \
    KRD(GL,0); GAPB(o[0]=__builtin_amdgcn_mfma_f32_32x32x16_bf16(PAF(1),VFR(1),o[0],0,0,0), C0,8); \
    KRD(GL,1); GAPB(o[1]=__builtin_amdgcn_mfma_f32_32x32x16_bf16(PAF(1),VFR(5),o[1],0,0,0), C0,12); \
    KRD(GL,2); GAPB(o[0]=__builtin_amdgcn_mfma_f32_32x32x16_bf16(PAF(2),VFR(2),o[0],0,0,0), C1,0); \
    KRD(GL,3); GAPB(o[1]=__builtin_amdgcn_mfma_f32_32x32x16_bf16(PAF(2),VFR(6),o[1],0,0,0), C1,4); \
    GAPB(o[0]=__builtin_amdgcn_mfma_f32_32x32x16_bf16(PAF(3),VFR(3),o[0],0,0,0), C1,8); \
    GAPB(o[1]=__builtin_amdgcn_mfma_f32_32x32x16_bf16(PAF(3),VFR(7),o[1],0,0,0), C1,12); \
    }while(0)
  int t=1;
  #undef CMASK
  #define CMASK(P0,P1,t) do{}while(0)
  for(;t+5<NT;t+=2){
    STEP(pB0,pB1,pA0,pA1,t,true,true,true);     WAIT_BAR(2); RESC(); ROT();
    STEP(pA0,pA1,pB0,pB1,t+1,true,true,true);   WAIT_BAR(2); RESC(); ROT();
  }
  #undef CMASK
  #define CMASK(P0,P1,t) do{int jb_=(t)-(NT-4); if(jb_>=0)cmask(P0,P1,jb_,qrel,hi);}while(0)
  #define ENDW(tt) do{ if((tt)+3<NT){WAIT_BAR(2);} else if((tt)+2<NT){WAIT_BAR(1);} else {WAIT_BAR(0);} }while(0)
  for(;t+1<NT;t+=2){
    STEP(pB0,pB1,pA0,pA1,t,(t+3<NT),(t+1<NT),(t+1<NT));       ENDW(t);   RESC(); ROT();
    STEP(pA0,pA1,pB0,pB1,t+1,(t+4<NT),(t+2<NT),(t+2<NT));     ENDW(t+1); RESC(); ROT();
  }
  STEP(pB0,pB1,pA0,pA1,NT-1,false,false,false); RESC();
  { float sacc=pB0[0]+pB0[1]; _Pragma("unroll") for(int r=2;r<16;++r)sacc+=pB0[r]; _Pragma("unroll") for(int r=0;r<16;++r)sacc+=pB1[r]; l_reg+=sacc;
    pw0=(u32x4){PKW(pB0,0),PKW(pB0,2),PKW(pB0,4),PKW(pB0,6)};pw1=(u32x4){PKW(pB0,8),PKW(pB0,10),PKW(pB0,12),PKW(pB0,14)};pw2=(u32x4){PKW(pB1,0),PKW(pB1,2),PKW(pB1,4),PKW(pB1,6)};pw3=(u32x4){PKW(pB1,8),PKW(pB1,10),PKW(pB1,12),PKW(pB1,14)};
    SBAR(); pv(o,vb0+sl_cur,PAF(0),PAF(1),PAF(2),PAF(3)); }
  #undef PKW
  #undef PAF
  #undef VFR
  #undef PIN
  #undef MX3
  #undef GAPA
  #undef GAPB
  #undef EX
  #undef VRD
  #undef KRD
  #undef STEP
  #undef ENDW
  {auto rr=__builtin_amdgcn_permlane32_swap(__float_as_uint(l_reg),__float_as_uint(l_reg),false,false);l_reg=__uint_as_float(rr[0])+__uint_as_float(rr[1]);}
  if(hi==0)wsf[32+r32]=l_reg;asm volatile("s_waitcnt lgkmcnt(0)":::"memory");
  float rli[16];
  #pragma unroll
  for(int r=0;r<16;++r)rli[r]=__builtin_amdgcn_rcpf(wsf[32+crow(r,hi)]);
  bf16*Ow=O+(rowbase+q0+wid*QBLK)*DM+h*D;
  { bf16*stg=(bf16*)(shm+LDS_OST)+wid*2048;
    #pragma unroll
    for(int r=0;r<16;++r){const int orow=crow(r,hi);
      #pragma unroll
      for(int d0=0;d0<2;++d0)stg[orow*64+d0*32+r32]=__float2bfloat16(o[d0][r]*rli[r]);}
    asm volatile("s_waitcnt lgkmcnt(0)":::"memory");
    #pragma unroll
    for(int i=0;i<4;++i){const int row=i*8+(lane>>3),ch=lane&7; const u32x4 v=*(const u32x4*)(stg+row*64+ch*8); ATTN_STORE16(Ow+(long)row*DM+ch*8,v);} }
  asm volatile("s_waitcnt lgkmcnt(0)\n\ts_barrier":::"memory");
  #undef DMA_K
  #undef DMA_V
  #undef CMASK
  #undef START
  #undef RESC
  #undef ROT
  #undef BINIT
}
constexpr int ATTN_LDS_BYTES=LDS_BYTES;
#undef SBAR
#undef WAIT_BAR
}


__device__ __forceinline__ void phase4(const Params& p, LAS char* lds) {
    char* shm = (char*)lds;
    const int bid = blockIdx.x;
    for (int v0 = bid; v0 < 256; v0 += gridDim.x) {
        const int v = (gridDim.x == 256) ? ((v0 & 7) * 32 + (v0 >> 3)) : v0;
        const int bh = v >> 2, s = v & 3;
#pragma unroll 1
        for (int i = 0; i < 4; ++i) {
            const int qb = (i == 0) ? s : (i == 1) ? 7 - s : (i == 2) ? 8 + s : 15 - s;
            attn_body::attn_unit<8>(bh / NH, bh % NH, qb, (const attn_body::bf16*)p.Qb, (const attn_body::bf16*)p.Kb, (const attn_body::bf16*)p.Vb, (attn_body::bf16*)p.Ob, p.Floc, p.Tsum, p.kmax2, p.qmax2, shm);
        }
    }
}
__device__ __forceinline__ void phase5(const Params& p, LAS char* lds) {
    LAS char* panel = lds + LDS_PANEL;
    for (int tile = blockIdx.x; tile < NTILE; tile += gridDim.x) {
        const int tid = launder(threadIdx.x), wid = __builtin_amdgcn_readfirstlane(tid >> 6), lane = tid & 63, r = lane & 15, q = lane >> 4;
        const int t0 = tile * 64;
        load_panel(p.Ob + (size_t)t0 * D, panel, tid);
        __syncthreads();
        f32x4 acc[8][4];
#pragma unroll
        for (int nt = 0; nt < 8; ++nt)
#pragma unroll
            for (int mt = 0; mt < 4; ++mt) acc[nt][mt] = (f32x4){0.f, 0.f, 0.f, 0.f};
        panel_mma<4, 0, 8>(acc, panel, 2048, 0, 32, p.wt_o, (8 * wid) * 32 * 512, 32 * 512, lane);
        panel_mma<4, 4, 8>(acc, panel, 2048, 0, 32, p.wt_o, (8 * wid + 4) * 32 * 512, 32 * 512, lane);
        const int colbase = 128 * wid;
        __syncthreads();
        load_panel(p.x2 + (size_t)t0 * D, panel, tid);
        __syncthreads();
#pragma unroll
        for (int mt = 0; mt < 4; ++mt) {
#pragma unroll
            for (int nt = 0; nt < 8; ++nt) {
                const int n = colbase + nt * 16 + 4 * q;
                const u32x2 cv = *(const LAS u32x2*)(panel + (mt * 16 + r) * 2048 + (((n >> 3) ^ r) << 4) + (n & 7) * 2);
                acc[nt][mt][0] = fmaf(ALPHA, bf_lo(cv.x), acc[nt][mt][0]); acc[nt][mt][1] = fmaf(ALPHA, bf_hi(cv.x), acc[nt][mt][1]);
                acc[nt][mt][2] = fmaf(ALPHA, bf_lo(cv.y), acc[nt][mt][2]); acc[nt][mt][3] = fmaf(ALPHA, bf_hi(cv.y), acc[nt][mt][3]);
            }
#pragma unroll
            for (int nt = 0; nt < 8; ++nt) VPIN(acc[nt][mt]);
            CFENCE();
        }
        ln_route_tail(p, 1, 0, acc, colbase, p.x3, lds, t0, tid);
    }
}
#define XB_TMO      128
#define XB_XCNT(j)  (256  + 64 * (j))
#define XB_XSUB(j)  (1280 + 64 * (j))
#define XB_XGEN(j)  (2304 + 64 * (j))
#define XB_TOP      3328
#define XB_TOPGEN   3392
#define XCD_BAR_WORDS 3456
#define XB_SPIN_CAP (1u << 18)

__device__ __forceinline__ unsigned xb_ld(unsigned* p)              { return __hip_atomic_load(p, __ATOMIC_RELAXED, __HIP_MEMORY_SCOPE_AGENT); }
__device__ __forceinline__ unsigned xb_add(unsigned* p, unsigned v) { return __hip_atomic_fetch_add(p, v, __ATOMIC_RELAXED, __HIP_MEMORY_SCOPE_AGENT); }
__device__ __forceinline__ unsigned xb_xcc_id() { return (unsigned)__builtin_amdgcn_s_getreg((3 << 11) | 20) & 0xFu; }
#define XB_SPIN(cond, bar) do { unsigned _sp = 0; while (cond) { __builtin_amdgcn_s_sleep(1); \
    if ((++_sp & 255u) == 0u) { if (xb_ld(&(bar)[XB_TMO])) break; if (_sp > XB_SPIN_CAP) { atomicAdd(&(bar)[XB_TMO], 1u); break; } } } } while (0)

struct XcdBarrier {
    unsigned* bar; unsigned x;
    volatile LAS unsigned* st;
};

__device__ __forceinline__ XcdBarrier xcd_barrier_post(unsigned* bar, volatile LAS unsigned* st) {
    XcdBarrier b; b.bar = bar; b.x = xb_xcc_id(); b.st = st;
    if (threadIdx.x == 0) (void)xb_add(&bar[XB_XCNT(b.x)], 1u);
    return b;
}
__device__ __forceinline__ void xcd_barrier_complete(unsigned* bar, unsigned x, unsigned& nloc, unsigned& nx) {
    const unsigned G = gridDim.x * gridDim.y * gridDim.z;
    unsigned sum, cnt, mine, sp = 0u;
    for (;;) {
        sum = 0u; cnt = 0u; mine = 0u;
#pragma unroll
        for (unsigned j = 0; j < 16; ++j) { const unsigned c = xb_ld(&bar[XB_XCNT(j)]); sum += c; cnt += (c > 0u) ? 1u : 0u; mine = (j == x) ? c : mine; }
        if (sum == G) break;
        __builtin_amdgcn_s_sleep(1);
        if ((++sp & 255u) == 0u) { if (xb_ld(&bar[XB_TMO])) break; if (sp > XB_SPIN_CAP) { atomicAdd(&bar[XB_TMO], 1u); break; } }
    }
    nloc = mine > 0u ? mine : 1u; nx = cnt > 0u ? cnt : 1u;
}

__device__ __forceinline__ void xcd_barrier(const XcdBarrier& b) {
    asm volatile("s_waitcnt vmcnt(0)" ::: "memory");
    __syncthreads();
    if (threadIdx.x == 0) {
        unsigned* bar = b.bar;
        __builtin_amdgcn_s_waitcnt(0);
        unsigned nloc = b.st[0], nx = b.st[1];
        if (nloc == 0u) { xcd_barrier_complete(bar, b.x, nloc, nx); b.st[0] = nloc; b.st[1] = nx; }
        const unsigned old = xb_add(&bar[XB_XSUB(b.x)], 1u);
        const unsigned gen = old / nloc;
        if (old + 1u == (gen + 1u) * nloc) {
            __builtin_amdgcn_fence(__ATOMIC_RELEASE, "agent");
            asm volatile("s_waitcnt vmcnt(0)" ::: "memory");
            const unsigned og = xb_add(&bar[XB_TOP], 1u);
            const unsigned tg = og / nx;
            if (og + 1u == (tg + 1u) * nx) xb_add(&bar[XB_TOPGEN], 1u);
            else XB_SPIN(xb_ld(&bar[XB_TOPGEN]) == tg, bar);
            __builtin_amdgcn_fence(__ATOMIC_ACQUIRE, "agent");
            xb_add(&bar[XB_XGEN(b.x)], 1u);
            asm volatile("s_waitcnt vmcnt(0)" ::: "memory");
        } else {
            XB_SPIN(xb_ld(&bar[XB_XGEN(b.x)]) == gen, bar);
            __builtin_amdgcn_fence(__ATOMIC_ACQUIRE, "agent");
            asm volatile("s_waitcnt vmcnt(0)" ::: "memory");
        }
    }
    __syncthreads();
}

extern __shared__ __attribute__((aligned(16))) unsigned char dyn_lds[];

__global__ void __launch_bounds__(512, 2) k_mega(Params p) {
    LAS char* lds = (LAS char*)dyn_lds;
    if (threadIdx.x == 0) *(LAS u32x4*)(lds + LDS_XB) = (u32x4){0u, 0u, 0u, 0u};
    __syncthreads();
    (void)xcd_barrier_post(p.bar, (volatile LAS unsigned*)(lds + LDS_XB));
#define GRID_BARRIER() do { XcdBarrier b_; b_.bar = p.bar; b_.x = xb_xcc_id(); b_.st = (volatile LAS unsigned*)(lds + LDS_XB); xcd_barrier(b_); } while (0)
    phase0a(p);                GRID_BARRIER();
    phase1(p, lds); phase0b(p); GRID_BARRIER();
    phase2a<0>(p, 0, lds);        GRID_BARRIER();
    phase2b<0>(p, 0, lds);        GRID_BARRIER();
    phase3<false>(p, 0, lds);  GRID_BARRIER();
    phase4(p, lds);            GRID_BARRIER();
    phase5(p, lds);            GRID_BARRIER();
    phase2a<0>(p, 1, lds);        GRID_BARRIER();
    phase2b<0>(p, 1, lds);        GRID_BARRIER();
    phase3<true>(p, 1, lds);
}
}

extern "C" void kernel_launch(void* const* d_in, const int* in_sizes, int n_in, void* d_out, int out_size, void* d_ws, size_t ws_size, hipStream_t stream) {
    using namespace nk;
    Params p{};
    p.x = (const float*)d_in[0]; p.pool_w = (const float*)d_in[1]; p.pool_scale = (const float*)d_in[2]; p.w_q = (const float*)d_in[3]; p.w_o = (const float*)d_in[4];
    p.w_kvf = (const float*)d_in[5]; p.b_f = (const float*)d_in[6]; p.ln_g = (const float*)d_in[7]; p.ln_b = (const float*)d_in[8]; p.router_w = (const float*)d_in[9];
    p.router_b = (const float*)d_in[10]; p.w_gate_up = (const float*)d_in[11]; p.w_down = (const float*)d_in[12]; p.ws_gate_up = (const float*)d_in[13]; p.ws_down = (const float*)d_in[14];
    p.out = (float*)d_out;
    char* ws = (char*)d_ws; size_t off = 0;
    auto alloc = [&](size_t bytes) { void* q = ws + off; off += (bytes + 255) & ~(size_t)255; return q; };
    p.bar = (unsigned*)alloc(16384); p.cnt = (int*)alloc(2 * NE * 4); p.kmax2 = (unsigned*)alloc(64 * 4); p.qmax2 = (unsigned*)alloc(1024 * 4);
    const size_t ctl_bytes = off;
    p.wt_pool = (bf16_t*)alloc(4 * 65536 * 2); p.wt_router = (bf16_t*)alloc((size_t)2 * D * NE * 2); p.wt_wsgu = (bf16_t*)alloc((size_t)2 * D * 512 * 2);
    p.wt_wsd = (bf16_t*)alloc((size_t)2 * FE * D * 2); p.wt_kvf = (bf16_t*)alloc((size_t)D * NKVF * 2); p.wt_q = (bf16_t*)alloc((size_t)D * D * 2); p.wt_o = (bf16_t*)alloc((size_t)D * D * 2);
    p.x1 = (bf16_t*)alloc((size_t)NTOK * D * 2); p.x2 = (bf16_t*)alloc((size_t)NTOK * D * 2); p.x3 = (bf16_t*)alloc((size_t)NTOK * D * 2);
    p.Kb = (bf16_t*)alloc((size_t)NTOK * D * 2); p.Vb = (bf16_t*)alloc((size_t)NTOK * D * 2); p.Qb = (bf16_t*)alloc((size_t)NTOK * D * 2); p.Ob = (bf16_t*)alloc((size_t)NTOK * D * 2);
    p.Floc = (float*)alloc((size_t)NB * NH * S * 4); p.Tsum = (float*)alloc(NB * NH * 64 * 4);
    p.ltok = (int*)alloc((size_t)NE * LCAP * 4); p.lw = (float*)alloc((size_t)NE * LCAP * 4); p.pe = (int*)alloc(NTOK * TOPK * 4); p.pp = (int*)alloc(NTOK * TOPK * 4);
    p.Hb = (bf16_t*)alloc((size_t)NTOK * TOPK * FE * 2); p.Y8 = (unsigned char*)alloc((size_t)NTOK * TOPK * D);
    if (off > ws_size) { fprintf(stderr, "workspace too small: need %zu have %zu\n", off, ws_size); return; }
    static int grid = 0;
    if (!grid) {
        int dev = 0, cus = 0, per_cu = 0;
        (void)hipGetDevice(&dev); (void)hipDeviceGetAttribute(&cus, hipDeviceAttributeMultiprocessorCount, dev);
        (void)hipFuncSetAttribute((const void*)k_mega, hipFuncAttributeMaxDynamicSharedMemorySize, LDS_TOTAL);
        if (hipOccupancyMaxActiveBlocksPerMultiprocessor(&per_cu, (const void*)k_mega, 512, LDS_TOTAL) != hipSuccess || per_cu < 1) { fprintf(stderr, "occupancy query: %d\n", per_cu); per_cu = 1; }
        (void)hipGetLastError();
        grid = cus * 1;
    }
    (void)hipMemsetAsync(ws, 0, ctl_bytes, stream);
    k_mega<<<grid, 512, LDS_TOTAL, stream>>>(p);
}
```

```cpp
#include <hip/hip_runtime.h>
#include <hip/hip_bf16.h>
#include <stdint.h>
#include <stdio.h>
#include <cmath>
namespace nk {
#define LAS __attribute__((address_space(3)))
typedef unsigned short bf16_t;
typedef short bf16x8 __attribute__((ext_vector_type(8)));
typedef short s16x4 __attribute__((ext_vector_type(4)));
typedef float f32x4 __attribute__((ext_vector_type(4)));
typedef float f32x2_t __attribute__((ext_vector_type(2)));
typedef __bf16 bf16x2_t __attribute__((ext_vector_type(2)));
typedef unsigned u32x2 __attribute__((ext_vector_type(2)));
typedef unsigned u32x4 __attribute__((ext_vector_type(4)));

constexpr int D = 1024, NB = 4, S = 4096, NTOK = NB * S, NH = 16, HD = 64, NE = 256, TOPK = 8, FE = 256;
constexpr int NKVF = 2 * D + NH;
constexpr int NTILE = NTOK / 64;
constexpr float ALPHA = 1.41421356237309515f, EPS = 1e-5f, ROUTED_SCALE = 2.5f, LOG2E = 1.4426950408889634f, C2 = 0.125f * 1.4426950408889634f;
constexpr float YSCALE = 16.0f;
constexpr int LCAP = NTOK;

constexpr int LDS_PANEL = 0;
constexpr int LDS_SCR = 131072;
constexpr int LDS_RED = LDS_SCR;
constexpr int LDS_BASE = LDS_SCR + 4096;
constexpr int LDS_MISC = LDS_SCR + 5120;
constexpr int LDS_XB = LDS_SCR + 12288 - 16;
constexpr int LDS_STAGE = LDS_SCR + 12288;
constexpr int LDS_TOTAL = 163840;

#define CFENCE() asm volatile("" ::: "memory")
#define LDS_BARRIER() do { asm volatile("s_waitcnt lgkmcnt(0)" ::: "memory"); __builtin_amdgcn_s_barrier(); asm volatile("" ::: "memory"); } while (0)
#define VPIN(x) asm volatile("" : "+v"(x))
__device__ __forceinline__ int launder(int v) { asm volatile("" : "+v"(v)); return v; }
__device__ __forceinline__ unsigned cvtpk(float lo, float hi) { f32x2_t v = {lo, hi}; bf16x2_t b = __builtin_convertvector(v, bf16x2_t); return __builtin_bit_cast(unsigned, b); }
__device__ __forceinline__ float bf_lo(unsigned u) { return __uint_as_float(u << 16); }
__device__ __forceinline__ float bf_hi(unsigned u) { return __uint_as_float(u & 0xffff0000u); }
__device__ __forceinline__ f32x4 mfma16(bf16x8 a, bf16x8 b, f32x4 c) { return __builtin_amdgcn_mfma_f32_16x16x32_bf16(a, b, c, 0, 0, 0); }
__device__ __forceinline__ float sigmoidf_(float x) { return 1.f / (1.f + __expf(-x)); }
__device__ __forceinline__ float siluf_(float x) { return x / (1.f + __expf(-x)); }

struct Params {
    const float* x; const float* pool_w; const float* pool_scale; const float* w_q; const float* w_o; const float* w_kvf; const float* b_f;
    const float* ln_g; const float* ln_b; const float* router_w; const float* router_b; const float* w_gate_up; const float* w_down;
    const float* ws_gate_up; const float* ws_down; float* out;
    unsigned* bar; int* cnt;
    unsigned* kmax2; unsigned* qmax2;
    bf16_t* wt_pool; bf16_t* wt_router; bf16_t* wt_wsgu; bf16_t* wt_wsd; bf16_t* wt_kvf; bf16_t* wt_q; bf16_t* wt_o;
    bf16_t* x1; bf16_t* x2; bf16_t* x3; bf16_t* Kb; bf16_t* Vb; bf16_t* Qb; bf16_t* Ob;
    float* Floc; float* Tsum;
    int* ltok; float* lw; int* pe; int* pp;
    bf16_t* Hb; unsigned char* Y8;
};

__device__ __forceinline__ void pretile(const float* __restrict__ W, int K, int N, int ld, bf16_t* __restrict__ out, int gtid, int gthreads) {
    const int KS = K / 32, items = (N / 16) * KS * 64;
    for (int it = gtid; it < items; it += gthreads) {
        const int lane = it & 63, tile = it >> 6, ks = tile % KS, nt = tile / KS;
        const float* src = W + (size_t)(ks * 32 + 8 * (lane >> 4)) * ld + nt * 16 + (lane & 15);
        u32x4 o;
        o.x = cvtpk(src[0], src[(size_t)ld]); o.y = cvtpk(src[(size_t)2 * ld], src[(size_t)3 * ld]);
        o.z = cvtpk(src[(size_t)4 * ld], src[(size_t)5 * ld]); o.w = cvtpk(src[(size_t)6 * ld], src[(size_t)7 * ld]);
        *(u32x4*)(out + (size_t)it * 8) = o;
    }
}
__device__ __forceinline__ void phase0a(const Params& p) {
    const int gtid = blockIdx.x * blockDim.x + threadIdx.x, gth = gridDim.x * blockDim.x;
    for (int g = 0; g < 4; ++g) pretile(p.pool_w + (size_t)g * 65536, 256, 256, 256, p.wt_pool + (size_t)g * 65536, gtid, gth);
    pretile(p.router_w, D, NE, NE, p.wt_router, gtid, gth);
}
__device__ __forceinline__ void phase0b(const Params& p) {
    const int gtid = blockIdx.x * blockDim.x + threadIdx.x, gth = gridDim.x * blockDim.x;
    pretile(p.router_w + (size_t)D * NE, D, NE, NE, p.wt_router + (size_t)D * NE, gtid, gth);
    for (int l = 0; l < 2; ++l) {
        pretile(p.ws_gate_up + (size_t)l * D * 512, D, 512, 512, p.wt_wsgu + (size_t)l * D * 512, gtid, gth);
        pretile(p.ws_down + (size_t)l * FE * D, FE, D, D, p.wt_wsd + (size_t)l * FE * D, gtid, gth);
    }
    pretile(p.w_kvf, D, NKVF, NKVF, p.wt_kvf, gtid, gth);
    pretile(p.w_q, D, D, D, p.wt_q, gtid, gth);
    pretile(p.w_o, D, D, D, p.wt_o, gtid, gth);
}

template <int NT, int NOFF, int NTOT, int PD = 4>
__device__ __forceinline__ void panel_mma(f32x4 (&acc)[NTOT][4], const LAS char* panel, const int row_bytes, const int kchunk0, const int ksteps,
                                          const bf16_t* __restrict__ wt, const int toff0, const int tstride, const int lane) {
    const int r = lane & 15, q = lane >> 4;
    const LAS char* arow = panel + r * row_bytes;
    const bf16x8* wp = (const bf16x8*)(wt + toff0) + lane;
    const int ts8 = tstride >> 3, last = ksteps - 1;
    const int rot = ((int)blockIdx.x >> 3) & last;
#define KROT(j) (((j) + rot) & last)
    bf16x8 b[PD][NT];
#pragma unroll
    for (int d = 0; d < PD; ++d)
#pragma unroll
        for (int nt = 0; nt < NT; ++nt) b[d][nt] = wp[nt * ts8 + KROT(d < ksteps ? d : last) * 64];
    bf16x8 a[4], an[4];
#pragma unroll
    for (int mt = 0; mt < 4; ++mt) a[mt] = *(const LAS bf16x8*)(arow + mt * 16 * row_bytes + (((kchunk0 + KROT(0) * 4 + q) ^ r) << 4));
    __builtin_amdgcn_sched_barrier(0);
#pragma unroll 1
    for (int ks = 0; ks < ksteps; ks += PD) {
#pragma unroll
        for (int d = 0; d < PD; ++d) {
            const int kn1 = KROT(ks + d + 1 < ksteps ? ks + d + 1 : last);
#pragma unroll
            for (int mt = 0; mt < 4; ++mt) an[mt] = *(const LAS bf16x8*)(arow + mt * 16 * row_bytes + (((kchunk0 + kn1 * 4 + q) ^ r) << 4));
#pragma unroll
            for (int nt = 0; nt < NT; ++nt)
#pragma unroll
                for (int mt = 0; mt < 4; ++mt) acc[NOFF + nt][mt] = mfma16(b[d][nt], a[mt], acc[NOFF + nt][mt]);
            const int kn = KROT(ks + d + PD < ksteps ? ks + d + PD : last);
            const int lofs = (ks + d + PD < ksteps) ? 0 : -lane;
#pragma unroll
            for (int nt = 0; nt < NT; ++nt) b[d][nt] = wp[nt * ts8 + kn * 64 + lofs];
            __builtin_amdgcn_sched_barrier(0);
#pragma unroll
            for (int mt = 0; mt < 4; ++mt) a[mt] = an[mt];
        }
    }
#undef KROT
    CFENCE();
}
template <int NT>
__device__ __forceinline__ void ln_stats(const f32x4 (&v)[NT][4], LAS float* red, int wid, int lane, float (&mean)[4], float (&rstd)[4]) {
    const int r = lane & 15, q = lane >> 4;
#pragma unroll
    for (int mt = 0; mt < 4; ++mt) {
        float s = 0.f, ss = 0.f;
#pragma unroll
        for (int nt = 0; nt < NT; ++nt)
#pragma unroll
            for (int i = 0; i < 4; ++i) { const float x = v[nt][mt][i]; s += x; ss = fmaf(x, x, ss); }
        s += __shfl_xor(s, 16); ss += __shfl_xor(ss, 16);
        s += __shfl_xor(s, 32); ss += __shfl_xor(ss, 32);
        if (q == 0) { red[(wid * 64 + mt * 16 + r) * 2] = s; red[(wid * 64 + mt * 16 + r) * 2 + 1] = ss; }
    }
    __syncthreads();
#pragma unroll
    for (int mt = 0; mt < 4; ++mt) {
        float s = 0.f, ss = 0.f;
#pragma unroll
        for (int w = 0; w < 8; ++w) { s += red[(w * 64 + mt * 16 + r) * 2]; ss += red[(w * 64 + mt * 16 + r) * 2 + 1]; }
        const float mu = s * (1.f / D); const float var = fmaxf(ss * (1.f / D) - mu * mu, 0.f);
        mean[mt] = mu; rstd[mt] = 1.0f / sqrtf(var + EPS);
    }
}

__device__ __forceinline__ void load_panel(const bf16_t* __restrict__ src, LAS char* panel, int tid_in) {
    const int tid = launder(tid_in);
#pragma unroll
    for (int i = 0; i < 16; ++i) {
        const int c = tid + i * 512, row = c >> 7, ch = c & 127;
        const u32x4 v = *(const u32x4*)(src + (size_t)row * D + ch * 8);
        *(LAS u32x4*)(panel + row * 2048 + ((ch ^ (row & 15)) << 4)) = v;
    }
}

__device__ __forceinline__ void store_panel(bf16_t* __restrict__ dst, const LAS char* panel, int tid_in) {
    const int tid = launder(tid_in);
#pragma unroll
    for (int i = 0; i < 16; ++i) {
        const int c = tid + i * 512, row = c >> 7, ch = c & 127;
        const u32x4 v = *(const LAS u32x4*)(panel + row * 2048 + ((ch ^ (row & 15)) << 4));
        *(u32x4*)(dst + (size_t)row * D + ch * 8) = v;
    }
}

template <int W>
__device__ __forceinline__ void poolmix_w(const float* __restrict__ x, int t0, int s0, LAS char* panel, int c) {
    float hx[W], hy[W];
#pragma unroll
    for (int j = 0; j < W; ++j) { hx[j] = 0.f; hy[j] = 0.f; }
    float sx = 0.f, sy = 0.f;
    if (s0 > 0) {
#pragma unroll
        for (int j = 0; j < W - 1; ++j) { const float2 v = *(const float2*)(x + (size_t)(t0 - (W - 1) + j) * D + c); hx[j] = v.x; hy[j] = v.y; sx += v.x; sy += v.y; }
    }
    for (int mb = 0; mb < 4; ++mb) {
        float2 v[16];
#pragma unroll
        for (int j = 0; j < 16; ++j) v[j] = *(const float2*)(x + (size_t)(t0 + mb * 16 + j) * D + c);
#pragma unroll
        for (int j = 0; j < 16; ++j) {
            const int m = mb * 16 + j; constexpr int dummy = 0; (void)dummy;
            const int slot = (j + W - 1) % W;
            sx += v[j].x - hx[slot]; sy += v[j].y - hy[slot]; hx[slot] = v[j].x; hy[slot] = v[j].y;
            const int n = (s0 + m + 1 < W) ? (s0 + m + 1) : W; const float inv = 1.0f / (float)n;
            const unsigned pk = cvtpk(sx * inv - v[j].x, sy * inv - v[j].y);
            *(LAS unsigned*)(panel + m * 2048 + ((((c >> 3)) ^ (m & 15)) << 4) + (c & 7) * 2) = pk;
        }
    }
}

__device__ __forceinline__ void route_topk(const Params& p, int l, LAS char* scb, int t0, int tid) {
    const int lane = tid & 63, tk = tid >> 3, g = tid & 7;
    float v[32];
    const LAS f32x4* sp = (const LAS f32x4*)(scb + tk * 1040 + g * 128);
    const float4* bp = (const float4*)(p.router_b + l * NE + g * 32);
#pragma unroll
    for (int i = 0; i < 8; ++i) { const f32x4 s4 = sp[i]; const float4 b4 = bp[i]; v[4 * i] = s4[0] + b4.x; v[4 * i + 1] = s4[1] + b4.y; v[4 * i + 2] = s4[2] + b4.z; v[4 * i + 3] = s4[3] + b4.w; }
    float m1 = -INFINITY, m2 = -INFINITY;
#pragma unroll
    for (int i = 0; i < 32; ++i) { const float xv = v[i]; m2 = fmaxf(m2, fminf(m1, xv)); m1 = fmaxf(m1, xv); }
    const float gs = m1 + m2;
    int rank = 0;
#pragma unroll
    for (int j = 0; j < 8; ++j) { const float og = __shfl(gs, (lane & ~7) + j); rank += ((og > gs) || (og == gs && j < g)) ? 1 : 0; }
    const bool sel = rank < 4;
    unsigned taken = 0u; int my_e = 0;
#pragma unroll 1
    for (int round = 0; round < TOPK; ++round) {
        float bv = -INFINITY; int bi = 0;
#pragma unroll
        for (int i = 0; i < 32; ++i) { const bool ok = !((taken >> i) & 1u) && (v[i] > bv); bv = ok ? v[i] : bv; bi = ok ? i : bi; }
        if (!sel) bv = -INFINITY;
        int be = g * 32 + bi;
#pragma unroll
        for (int off = 1; off < 8; off <<= 1) { const float ov = __shfl_xor(bv, off); const int oe = __shfl_xor(be, off); const bool tk2 = (ov > bv) || (ov == bv && oe < be); bv = tk2 ? ov : bv; be = tk2 ? oe : be; }
        if ((be >> 5) == g) taken |= 1u << (be & 31);
        if (round == g) my_e = be;
    }
    const float sk = *(const LAS float*)(scb + tk * 1040 + my_e * 4);
    float sum = sk; sum += __shfl_xor(sum, 1); sum += __shfl_xor(sum, 2); sum += __shfl_xor(sum, 4);
    const float gw = sk / sum * ROUTED_SCALE;
    const int t = t0 + tk;
    const int pos = atomicAdd(p.cnt + l * NE + my_e, 1);
    p.ltok[(size_t)my_e * LCAP + pos] = t * TOPK + g; p.lw[(size_t)my_e * LCAP + pos] = gw;
}

__device__ __forceinline__ void ln_route_tail(const Params& p, int l, int which_ln, f32x4 (&v)[8][4], const int colbase, bf16_t* __restrict__ xout, LAS char* lds, int t0, int tid_in) {
    int tid = launder(tid_in);
    const int wid = __builtin_amdgcn_readfirstlane(tid >> 6), lane = tid & 63, r = lane & 15, q = lane >> 4;
    LAS char* panel = lds + LDS_PANEL; LAS float* red = (LAS float*)(lds + LDS_RED);
    float mean[4], rstd[4];
    ln_stats<8>(v, red, wid, lane, mean, rstd);
    const float* lg = p.ln_g + (l * 2 + which_ln) * D; const float* lb = p.ln_b + (l * 2 + which_ln) * D;
#pragma unroll
    for (int nt = 0; nt < 8; ++nt) {
        const int n = colbase + nt * 16 + 4 * q;
        const float4 g4 = *(const float4*)(lg + n), b4 = *(const float4*)(lb + n);
#pragma unroll
        for (int mt = 0; mt < 4; ++mt) {
            const int m = mt * 16 + r;
            const float y0 = (v[nt][mt][0] - mean[mt]) * rstd[mt] * g4.x + b4.x, y1 = (v[nt][mt][1] - mean[mt]) * rstd[mt] * g4.y + b4.y;
            const float y2 = (v[nt][mt][2] - mean[mt]) * rstd[mt] * g4.z + b4.z, y3 = (v[nt][mt][3] - mean[mt]) * rstd[mt] * g4.w + b4.w;
            u32x2 o; o.x = cvtpk(y0, y1); o.y = cvtpk(y2, y3);
            *(LAS u32x2*)(panel + m * 2048 + ((((n >> 3)) ^ r) << 4) + (n & 7) * 2) = o;
        }
        CFENCE();
    }
    __syncthreads();
    store_panel(xout + (size_t)t0 * D, panel, tid);
    f32x4 ra[2][4];
#pragma unroll
    for (int nt = 0; nt < 2; ++nt)
#pragma unroll
        for (int mt = 0; mt < 4; ++mt) ra[nt][mt] = (f32x4){0.f, 0.f, 0.f, 0.f};
    panel_mma<2, 0, 2>(ra, panel, 2048, 0, 32, p.wt_router + (size_t)l * D * NE, (2 * wid) * 32 * 512, 32 * 512, lane);
    __syncthreads();
    LAS char* scb = panel;
#pragma unroll
    for (int nt = 0; nt < 2; ++nt)
#pragma unroll
        for (int mt = 0; mt < 4; ++mt) {
            f32x4 s4; s4[0] = sigmoidf_(ra[nt][mt][0]); s4[1] = sigmoidf_(ra[nt][mt][1]); s4[2] = sigmoidf_(ra[nt][mt][2]); s4[3] = sigmoidf_(ra[nt][mt][3]);
            *(LAS f32x4*)(scb + (mt * 16 + r) * 1040 + (32 * wid + nt * 16 + 4 * q) * 4) = s4;
        }
    __syncthreads();
    route_topk(p, l, scb, t0, launder(tid));
    __syncthreads();
}

__device__ __forceinline__ void phase1(const Params& p, LAS char* lds) {
    LAS char* panel = lds + LDS_PANEL;
    for (int tile = blockIdx.x; tile < NTILE; tile += gridDim.x) {
        const int tid = launder(threadIdx.x), wid = __builtin_amdgcn_readfirstlane(tid >> 6), lane = tid & 63, r = lane & 15, q = lane >> 4;
        const int t0 = tile * 64, s0 = t0 % S;
        { const int c = 2 * tid;
          switch (wid >> 1) { case 0: poolmix_w<2>(p.x, t0, s0, panel, c); break; case 1: poolmix_w<4>(p.x, t0, s0, panel, c); break;
                              case 2: poolmix_w<8>(p.x, t0, s0, panel, c); break; default: poolmix_w<16>(p.x, t0, s0, panel, c); break; } }
        __syncthreads();
        f32x4 acc[8][4];
#pragma unroll
        for (int nt = 0; nt < 8; ++nt)
#pragma unroll
            for (int mt = 0; mt < 4; ++mt) acc[nt][mt] = (f32x4){0.f, 0.f, 0.f, 0.f};
        const int g = wid >> 1, hf = wid & 1;
        panel_mma<4, 0, 8>(acc, panel, 2048, g * 32, 8, p.wt_pool, g * 65536 + (hf * 8) * 8 * 512, 8 * 512, lane);
        panel_mma<4, 4, 8>(acc, panel, 2048, g * 32, 8, p.wt_pool, g * 65536 + (hf * 8 + 4) * 8 * 512, 8 * 512, lane);
        const int colbase = g * 256 + hf * 128;
#pragma unroll
        for (int nt = 0; nt < 8; ++nt) {
            const int n = colbase + nt * 16 + 4 * q;
            const float4 sc = *(const float4*)(p.pool_scale + n);
#pragma unroll
            for (int mt = 0; mt < 4; ++mt) {
                const float4 xr = *(const float4*)(p.x + (size_t)(t0 + mt * 16 + r) * D + n);
                acc[nt][mt][0] = fmaf(acc[nt][mt][0], sc.x, ALPHA * xr.x); acc[nt][mt][1] = fmaf(acc[nt][mt][1], sc.y, ALPHA * xr.y);
                acc[nt][mt][2] = fmaf(acc[nt][mt][2], sc.z, ALPHA * xr.z); acc[nt][mt][3] = fmaf(acc[nt][mt][3], sc.w, ALPHA * xr.w);
            }
            VPIN(acc[nt][0]); VPIN(acc[nt][1]); VPIN(acc[nt][2]); VPIN(acc[nt][3]); CFENCE();
        }
        ln_route_tail(p, 0, 0, acc, colbase, p.x1, lds, t0, tid);
    }
}
#define XB_TMO      128
#define XB_XCNT(j)  (256  + 64 * (j))
#define XB_XSUB(j)  (1280 + 64 * (j))
#define XB_XGEN(j)  (2304 + 64 * (j))
#define XB_TOP      3328
#define XB_TOPGEN   3392
#define XCD_BAR_WORDS 3456
#define XB_SPIN_CAP (1u << 18)

__device__ __forceinline__ unsigned xb_ld(unsigned* p)              { return __hip_atomic_load(p, __ATOMIC_RELAXED, __HIP_MEMORY_SCOPE_AGENT); }
__device__ __forceinline__ unsigned xb_add(unsigned* p, unsigned v) { return __hip_atomic_fetch_add(p, v, __ATOMIC_RELAXED, __HIP_MEMORY_SCOPE_AGENT); }
__device__ __forceinline__ unsigned xb_xcc_id() { return (unsigned)__builtin_amdgcn_s_getreg((3 << 11) | 20) & 0xFu; }
#define XB_SPIN(cond, bar) do { unsigned _sp = 0; while (cond) { __builtin_amdgcn_s_sleep(1); \
    if ((++_sp & 255u) == 0u) { if (xb_ld(&(bar)[XB_TMO])) break; if (_sp > XB_SPIN_CAP) { atomicAdd(&(bar)[XB_TMO], 1u); break; } } } } while (0)

struct XcdBarrier {
    unsigned* bar; unsigned x;
    volatile LAS unsigned* st;
};

__device__ __forceinline__ XcdBarrier xcd_barrier_post(unsigned* bar, volatile LAS unsigned* st) {
    XcdBarrier b; b.bar = bar; b.x = xb_xcc_id(); b.st = st;
    if (threadIdx.x == 0) (void)xb_add(&bar[XB_XCNT(b.x)], 1u);
    return b;
}
__device__ __forceinline__ void xcd_barrier_complete(unsigned* bar, unsigned x, unsigned& nloc, unsigned& nx) {
    const unsigned G = gridDim.x * gridDim.y * gridDim.z;
    unsigned sum, cnt, mine, sp = 0u;
    for (;;) {
        sum = 0u; cnt = 0u; mine = 0u;
#pragma unroll
        for (unsigned j = 0; j < 16; ++j) { const unsigned c = xb_ld(&bar[XB_XCNT(j)]); sum += c; cnt += (c > 0u) ? 1u : 0u; mine = (j == x) ? c : mine; }
        if (sum == G) break;
        __builtin_amdgcn_s_sleep(1);
        if ((++sp & 255u) == 0u) { if (xb_ld(&bar[XB_TMO])) break; if (sp > XB_SPIN_CAP) { atomicAdd(&bar[XB_TMO], 1u); break; } }
    }
    nloc = mine > 0u ? mine : 1u; nx = cnt > 0u ? cnt : 1u;
}

__device__ __forceinline__ void xcd_barrier(const XcdBarrier& b) {
    asm volatile("s_waitcnt vmcnt(0)" ::: "memory");
    __syncthreads();
    if (threadIdx.x == 0) {
        unsigned* bar = b.bar;
        __builtin_amdgcn_s_waitcnt(0);
        unsigned nloc = b.st[0], nx = b.st[1];
        if (nloc == 0u) { xcd_barrier_complete(bar, b.x, nloc, nx); b.st[0] = nloc; b.st[1] = nx; }
        const unsigned old = xb_add(&bar[XB_XSUB(b.x)], 1u);
        const unsigned gen = old / nloc;
        if (old + 1u == (gen + 1u) * nloc) {
            __builtin_amdgcn_fence(__ATOMIC_RELEASE, "agent");
            asm volatile("s_waitcnt vmcnt(0)" ::: "memory");
            const unsigned og = xb_add(&bar[XB_TOP], 1u);
            const unsigned tg = og / nx;
            if (og + 1u == (tg + 1u) * nx) xb_add(&bar[XB_TOPGEN], 1u);
            else XB_SPIN(xb_ld(&bar[XB_TOPGEN]) == tg, bar);
            __builtin_amdgcn_fence(__ATOMIC_ACQUIRE, "agent");
            xb_add(&bar[XB_XGEN(b.x)], 1u);
            asm volatile("s_waitcnt vmcnt(0)" ::: "memory");
        } else {
            XB_SPIN(xb_ld(&bar[XB_XGEN(b.x)]) == gen, bar);
            __builtin_amdgcn_fence(__ATOMIC_ACQUIRE, "agent");
            asm volatile("s_waitcnt vmcnt(0)" ::: "memory");
        }
    }
    __syncthreads();
}

__device__ __forceinline__ void xcd_barrier_arrive(const XcdBarrier& b) {
    asm volatile("s_waitcnt vmcnt(0)" ::: "memory");
    __syncthreads();
    if (threadIdx.x == 0) {
        unsigned* bar = b.bar;
        __builtin_amdgcn_s_waitcnt(0);
        unsigned nloc = b.st[0], nx = b.st[1];
        if (nloc == 0u) { xcd_barrier_complete(bar, b.x, nloc, nx); b.st[0] = nloc; b.st[1] = nx; }
        const unsigned old = xb_add(&bar[XB_XSUB(b.x)], 1u);
        const unsigned gen = old / nloc;
        b.st[2] = gen;
        if (old + 1u == (gen + 1u) * nloc) {
            __builtin_amdgcn_fence(__ATOMIC_RELEASE, "agent");
            asm volatile("s_waitcnt vmcnt(0)" ::: "memory");
            const unsigned og = xb_add(&bar[XB_TOP], 1u);
            const unsigned tg = og / nx;
            if (og + 1u == (tg + 1u) * nx) xb_add(&bar[XB_TOPGEN], 1u);
        }
    }
}
__device__ __forceinline__ void xcd_barrier_wait(const XcdBarrier& b) {
    __syncthreads();
    if (threadIdx.x == 0) {
        unsigned* bar = b.bar;
        const unsigned gen = b.st[2];
        XB_SPIN((int)(xb_ld(&bar[XB_TOPGEN]) - (gen + 1u)) < 0, bar);
        __builtin_amdgcn_fence(__ATOMIC_ACQUIRE, "agent");
        asm volatile("s_waitcnt vmcnt(0)" ::: "memory");
    }
    __syncthreads();
}
__device__ __forceinline__ void grid_arrive(unsigned* bar, LAS char* lds) { XcdBarrier b_; b_.bar = bar; b_.x = xb_xcc_id(); b_.st = (volatile LAS unsigned*)(lds + LDS_XB); xcd_barrier_arrive(b_); }
__device__ __forceinline__ void grid_wait(unsigned* bar, LAS char* lds) { XcdBarrier b_; b_.bar = bar; b_.x = xb_xcc_id(); b_.st = (volatile LAS unsigned*)(lds + LDS_XB); xcd_barrier_wait(b_); }
constexpr int EXP_RS = 288, EXP_BUF = 64 * EXP_RS;
__device__ __forceinline__ int exp_g(int k) { return (k & 3) | (((k >> 3) & 1) << 2); }
constexpr int XA_BUF = 8192, XA_WAVE = 2 * XA_BUF;
constexpr int XW_OFF = 131072, XW_RS = 256, XW_BUF = 64 * XW_RS;
__device__ __forceinline__ void dma16_asm(unsigned voff, const void* sbase, unsigned lds_dst) {
    unsigned keep;
    asm volatile("s_mov_b32 %0, m0\n\ts_mov_b32 m0, %3\n\ts_nop 0\n\tglobal_load_lds_dwordx4 %1, %2\n\ts_mov_b32 m0, %0" : "=&s"(keep) : "v"(voff), "s"(sbase), "s"(lds_dst) : "memory");
}
template <int NMT, int PM>
__device__ __forceinline__ void expert_loop(f32x4 (&acc)[8][4], LAS char* lds, const bf16_t* __restrict__ A, const unsigned (&aoffp)[8], const int nsteps,
                                            const float* __restrict__ wbase, const unsigned wvoff, const int ldw, LAS char* wdst, const int wslot, const LAS char* rb3_in,
                                            const unsigned adma, const LAS char* aread0_in) {
    const int last = nsteps - 1;
    f32x4 wa[4], wb[4];
    const size_t wstep = (size_t)64 * ldw * 4;
#define W_LOAD1(dst, st, i) if (PM != 5) { const char* b_ = (const char*)wbase + (size_t)(st) * wstep + (size_t)((i) >> 1) * 2 * ldw * 4; \
        if ((i) & 1) asm volatile("global_load_dwordx4 %0, %1, %2 offset:2048" : "=&v"(dst[i]) : "v"(wvo), "s"(b_) : "memory"); \
        else asm volatile("global_load_dwordx4 %0, %1, %2" : "=&v"(dst[i]) : "v"(wvo), "s"(b_) : "memory"); }
#define W_STORE1(src, bufoff, i) if (PM != 5) { u32x2 o; o.x = cvtpk(src[i][0], src[i][1]); o.y = cvtpk(src[i][2], src[i][3]); *(LAS u32x2*)(wdst + (bufoff) + (i) * XW_RS + ((wslot ^ (i)) << 5)) = o; }
#define A_DMA1(st, abuf, pc) if (PM != 7 && (pc) < 2 * NMT) { dma16_asm(aoffp[pc] & amask, (const char*)A + (size_t)(st) * 128, adma + (abuf) + (pc) * 1024); }
#define WAIT_TOP(w) asm volatile("s_waitcnt vmcnt(4)" : "+v"(w[0]), "+v"(w[1]), "+v"(w[2]), "+v"(w[3]) :: "memory")
#define B_READ(dst, cur, ks, nt) { const LAS char* bp = (const LAS char*)((unsigned)(size_t)rb3_in ^ ((nt) << 5)) + (cur) + (ks) * 32 * XW_RS; \
        const s16x4 lo = __builtin_bit_cast(s16x4, __builtin_amdgcn_ds_read_tr16_b64_v4i16((LAS s16x4*)bp)); \
        const s16x4 hi = __builtin_bit_cast(s16x4, __builtin_amdgcn_ds_read_tr16_b64_v4i16((LAS s16x4*)(bp + 4 * XW_RS))); \
        dst = (bf16x8){lo[0], lo[1], lo[2], lo[3], hi[0], hi[1], hi[2], hi[3]}; }
#define MMA_STEP(wcur, wnxt, acur, anxt, wst, sa, sw) { \
        const LAS char* ar0 = aread0_in + (acur); const LAS char* ar1 = (const LAS char*)((unsigned)(size_t)ar0 ^ 64u); \
        bf16x8 af[NMT], bq, bn; \
        _Pragma("unroll") for (int mt = 0; mt < NMT; ++mt) af[mt] = *(const LAS bf16x8*)(ar0 + mt * 2048); \
        B_READ(bq, wcur, 0, 0); \
        _Pragma("unroll") for (int g = 0; g < 16; ++g) { \
            if (g < 15) { B_READ(bn, wcur, (g + 1) >> 3, (g + 1) & 7); } \
            if (PM != 4) { _Pragma("unroll") for (int mt = 0; mt < NMT; ++mt) acc[g & 7][mt] = mfma16(bq, af[mt], acc[g & 7][mt]); } else asm volatile("" :: "v"(bq), "v"(af[0])); \
            if (g == 7) { _Pragma("unroll") for (int mt = 0; mt < NMT; ++mt) af[mt] = *(const LAS bf16x8*)(ar1 + mt * 2048); } \
            if (g < 4) { W_STORE1(wst, wnxt, g); } else if (g < 12) { A_DMA1(sa, anxt, g - 4); } else { W_LOAD1(wst, sw, g - 12); } \
            bq = bn; \
            __builtin_amdgcn_sched_barrier(0); } }
    unsigned wvo = wvoff, amask = 0xFFFFFFFFu;
    W_LOAD1(wa, 0, 0); W_LOAD1(wa, 0, 1); W_LOAD1(wa, 0, 2); W_LOAD1(wa, 0, 3);
#pragma unroll
    for (int pc = 0; pc < 8; ++pc) A_DMA1(0, 0, pc);
    { const int s1 = 1 < nsteps ? 1 : last; W_LOAD1(wb, s1, 0); W_LOAD1(wb, s1, 1); W_LOAD1(wb, s1, 2); W_LOAD1(wb, s1, 3); }
    asm volatile("s_waitcnt vmcnt(%4)" : "+v"(wa[0]), "+v"(wa[1]), "+v"(wa[2]), "+v"(wa[3]) : "n"(2 * NMT + 4) : "memory");
    W_STORE1(wa, 0, 0); W_STORE1(wa, 0, 1); W_STORE1(wa, 0, 2); W_STORE1(wa, 0, 3);
    { const int s2 = 2 < nsteps ? 2 : last; W_LOAD1(wa, s2, 0); W_LOAD1(wa, s2, 1); W_LOAD1(wa, s2, 2); W_LOAD1(wa, s2, 3); }
    LDS_BARRIER();
#pragma unroll 1
    for (int s = 0; s < nsteps; s += 2) {
        WAIT_TOP(wb);
        { const int sw = s + 3 < nsteps ? s + 3 : last; wvo = (s + 3 < nsteps) ? wvoff : 0u; amask = 0xFFFFFFFFu; MMA_STEP(0, XW_BUF, 0, XA_BUF, wb, s + 1, sw); }
        LDS_BARRIER();
        WAIT_TOP(wa);
        { const int sa = s + 2 < nsteps ? s + 2 : last, sw = s + 4 < nsteps ? s + 4 : last; wvo = (s + 4 < nsteps) ? wvoff : 0u; amask = (s + 2 < nsteps) ? 0xFFFFFFFFu : 0u; MMA_STEP(XW_BUF, 0, XA_BUF, 0, wa, sa, sw); }
        LDS_BARRIER();
    }
    asm volatile("s_waitcnt vmcnt(0)" ::: "memory");
    LDS_BARRIER();
#undef W_LOAD1
#undef W_STORE1
#undef A_DMA1
#undef WAIT_TOP
#undef B_READ
#undef MMA_STEP
}
template <int PM = 0>
__device__ __forceinline__ void expert_gemm1(f32x4 (&acc)[8][4], LAS char* lds, const bf16_t* __restrict__ A, const unsigned (&aoffp)[8],
                                             const float* __restrict__ W, const int ldw, const int col0, const int col1, const int nmt, const int tid) {
    const int lane = tid & 63, r = lane & 15, q = lane >> 4, wid = __builtin_amdgcn_readfirstlane(tid >> 6);
    const int n4 = tid & 31, kp = tid >> 5;
    const unsigned wvoff = (unsigned)(((4 * kp) * ldw + (n4 < 16 ? col0 + 4 * n4 : col1 + 4 * (n4 - 16))) * 4);
    LAS char* wdst = lds + XW_OFF + (4 * kp) * XW_RS + (n4 & 3) * 8;
    const int wslot = (n4 >> 2) ^ (((kp >> 1) & 1) << 2);
    const int rrow = 8 * q + (r >> 2);
    const LAS char* rb3 = lds + XW_OFF + rrow * XW_RS + (r & 3) * 8 + (exp_g(rrow) << 5);
    const unsigned adma = (unsigned)(size_t)(lds + wid * XA_WAVE);
    const LAS char* aread0 = lds + wid * XA_WAVE + r * 128 + (((q ^ (r >> 1)) & 7) << 4);
    const int nsteps = 16;
    switch (nmt) {
        case 1: expert_loop<1, PM>(acc, lds, A, aoffp, nsteps, W, wvoff, ldw, wdst, wslot, rb3, adma, aread0); break;
        case 2: expert_loop<2, PM>(acc, lds, A, aoffp, nsteps, W, wvoff, ldw, wdst, wslot, rb3, adma, aread0); break;
        case 3: expert_loop<3, PM>(acc, lds, A, aoffp, nsteps, W, wvoff, ldw, wdst, wslot, rb3, adma, aread0); break;
        default: expert_loop<4, PM>(acc, lds, A, aoffp, nsteps, W, wvoff, ldw, wdst, wslot, rb3, adma, aread0); break;
    }
}

constexpr int EMT = 4;
template <int PM>
__device__ __forceinline__ void gemm1_unit(const Params& p, int l, int e, int cnt, int base, int j_in, LAS char* lds, int tid_in) {
    const int j = (PM == 1) ? 0 : j_in;
    const float* w1 = p.w_gate_up + ((size_t)l * NE + e) * D * 512;
    const int* ltok = p.ltok + (size_t)e * LCAP; const float* lw = p.lw + (size_t)e * LCAP;
    const bf16_t* xin = l ? p.x3 : p.x1;
    for (int r0 = 0; r0 < cnt; r0 += 128 * EMT) {
        const int tid = launder(tid_in), wid = __builtin_amdgcn_readfirstlane(tid >> 6), lane = tid & 63, r = lane & 15, q = lane >> 4;
        const int nrows = (cnt - r0 < 128 * EMT) ? (cnt - r0) : 128 * EMT;
        const int nmt = (nrows + 127) >> 7, wrb = r0 + wid * nmt * 16;
        unsigned aoffp[8];
#pragma unroll
        for (int pc = 0; pc < 8; ++pc) {
            const int row = wrb + 8 * pc + (lane >> 3);
            const int rr = ((pc < 2 * nmt) && (row < r0 + nrows)) ? row : r0;
            aoffp[pc] = (PM == 2 ? 0u : (unsigned)(ltok[rr] >> 3)) * (D * 2) + (unsigned)(((lane & 7) ^ (4 * (pc & 1) + (lane >> 4))) << 4);
        }
        f32x4 acc[8][EMT];
#pragma unroll
        for (int nt = 0; nt < 8; ++nt)
#pragma unroll
            for (int mt = 0; mt < EMT; ++mt) acc[nt][mt] = (f32x4){0.f, 0.f, 0.f, 0.f};
        expert_gemm1<PM>(acc, lds, xin, aoffp, w1, 512, 64 * j, 256 + 64 * j, nmt, tid);
        {
            const int tid2 = launder(tid), lane2 = tid2 & 63, r2 = lane2 & 15, q2 = lane2 >> 4;
            const int wrb2 = r0 + __builtin_amdgcn_readfirstlane(tid2 >> 6) * nmt * 16;
#pragma unroll
            for (int mt = 0; mt < EMT; ++mt) {
                const int row = wrb2 + mt * 16 + r2;
                if ((mt < nmt) && (row < r0 + nrows)) {
                    const float gw = lw[row];
                    bf16_t* hp = (PM ? p.Ob + (size_t)((base + row) & 1023) * FE : p.Hb + (size_t)(base + row) * FE) + 64 * j_in + 4 * q2;
#pragma unroll
                    for (int nt = 0; nt < 4; ++nt) {
                        const f32x4 g = acc[nt][mt], u = acc[nt + 4][mt];
                        u32x2 o; o.x = cvtpk(siluf_(g[0]) * u[0] * gw, siluf_(g[1]) * u[1] * gw); o.y = cvtpk(siluf_(g[2]) * u[2] * gw, siluf_(g[3]) * u[3] * gw);
                        *(u32x2*)(hp + nt * 16) = o;
                    }
                }
            }
        }
    }
}
__device__ __forceinline__ void expert_bases(const int* __restrict__ cnt, LAS int* basel, int tid_in) {
    const int tid = launder(tid_in);
    if (tid < 64) {
        const int4 c = *(const int4*)(cnt + 4 * tid);
        const int s4 = c.x + c.y + c.z + c.w; int inc = s4;
#pragma unroll
        for (int o = 1; o < 64; o <<= 1) { const int t = __shfl_up(inc, o); if (tid >= o) inc += t; }
        const int ex = inc - s4;
        basel[4 * tid] = ex; basel[4 * tid + 1] = ex + c.x; basel[4 * tid + 2] = ex + c.x + c.y; basel[4 * tid + 3] = ex + c.x + c.y + c.z;
    }
    __syncthreads();
}

template <int PM>
__device__ __forceinline__ void phase2a(const Params& p, int l, LAS char* lds) {
    const int tid = threadIdx.x;
    LAS int* basel = (LAS int*)(lds + LDS_BASE);
    const int* cnt = p.cnt + l * NE;
    const unsigned xb0 = *(volatile LAS unsigned*)(lds + LDS_XB), xb1 = *(volatile LAS unsigned*)(lds + LDS_XB + 4);
    expert_bases(cnt, basel, tid);
    if (gridDim.x == 256) {
        LAS int* sorted = (LAS int*)(lds + LDS_MISC);
        {
            const int lane = tid & 63, wv = tid >> 6;
            int cst[4];
#pragma unroll
            for (int jj = 0; jj < 4; ++jj) { const int c = cnt[lane + 64 * jj]; cst[jj] = c + (c > 128 * EMT ? 224 : 0); }
            for (int i = 0; i < 32; ++i) {
                const int e = wv * 32 + i;
                const int ce0 = cnt[e]; const int ce = ce0 + (ce0 > 128 * EMT ? 224 : 0);
                int rk = 0;
#pragma unroll
                for (int jj = 0; jj < 4; ++jj) { const int id = lane + 64 * jj; rk += __popcll(__ballot(cst[jj] > ce || (cst[jj] == ce && id < e))); }
                if (lane == 0) sorted[rk] = e;
            }
        }
        __syncthreads();
        const int x = blockIdx.x & 7, rank = blockIdx.x >> 3, j = rank & 3, g = x + 8 * (rank >> 2);
        int ue[4], ub[4];
#pragma unroll
        for (int rd = 0; rd < 4; ++rd) { ue[rd] = __builtin_amdgcn_readfirstlane(sorted[rd * 64 + ((rd & 1) ? 63 - g : g)]); ub[rd] = __builtin_amdgcn_readfirstlane(basel[ue[rd]]); }
        __syncthreads();
#pragma unroll 1
        for (int rd0 = 0; rd0 < 4; ++rd0) { const int rd = (g & 8) ? 3 - rd0 : rd0;
            const int e = rd == 0 ? ue[0] : rd == 1 ? ue[1] : rd == 2 ? ue[2] : ue[3], bs = rd == 0 ? ub[0] : rd == 1 ? ub[1] : rd == 2 ? ub[2] : ub[3];
            gemm1_unit<PM>(p, l, e, cnt[e], bs, j, lds, tid); }
    } else {
        for (int u = blockIdx.x; u < NE * 4; u += gridDim.x) {
            const int e = u >> 2, j = u & 3;
            expert_bases(cnt, basel, tid); const int bs = __builtin_amdgcn_readfirstlane(basel[e]); __syncthreads();
            gemm1_unit<PM>(p, l, e, cnt[e], bs, j, lds, tid);
            __syncthreads();
        }
    }
    __syncthreads();
    if (tid == 0) { *(volatile LAS unsigned*)(lds + LDS_XB) = xb0; *(volatile LAS unsigned*)(lds + LDS_XB + 4) = xb1; }
    __syncthreads();
}

constexpr int P2B_RS = 128, P2B_BUF = 256 * P2B_RS;
__device__ __forceinline__ int p2b_g(int k) { return ((k >> 1) & 1) | (((k >> 3) & 1) << 1); }
template <int PM, int TPW>
__device__ __forceinline__ void gemm2_block(const Params& p, int l, int e, int base, int row0, int rows, LAS char* lds, int tid_in,
                                            const float* __restrict__ w2n  , const bool have  , f32x4 (&wr)[8]) {
    const int tid = launder(tid_in), wid = __builtin_amdgcn_readfirstlane(tid >> 6), lane = tid & 63, r = lane & 15, q = lane >> 4;
    const float* w2 = p.w_down + ((size_t)l * NE + e) * FE * D;
    const int* ltok = p.ltok + (size_t)e * LCAP + row0;
    const int T = (rows + 15) >> 4;
    const bool active = (TPW * wid) < T;
    bf16x8 hf[TPW][8];
    {
#pragma unroll
        for (int mt = 0; mt < TPW; ++mt) {
            int row = (TPW * wid + mt) * 16 + r; if (row >= rows) row = 0;
            const bf16_t* hp = p.Hb + (size_t)(base + row0 + row) * FE + 8 * q;
#pragma unroll
            for (int ks = 0; ks < 8; ++ks) hf[mt][ks] = *(const bf16x8*)(hp + ks * 32);
        }
    }
    const int n4 = tid & 15, kq = tid >> 4;
    const float* wsrc = w2 + (size_t)kq * D + 4 * n4;
    LAS char* wdst = lds + kq * P2B_RS + (((n4 >> 2) ^ p2b_g(kq)) << 5) + (n4 & 3) * 8;
    const int rrow = 8 * q + (r >> 2);
    const LAS char* rbase = lds + rrow * P2B_RS + (r & 3) * 8; const int rg = p2b_g(rrow);
    int yslot[2 * TPW];
#pragma unroll
    for (int rr = 0; rr < 2 * TPW; ++rr) { const int row = TPW * wid * 16 + rr * 8 + (lane >> 3); yslot[rr] = ltok[row < rows ? row : 0]; }
    if (PM == 3 || PM == 4) { for (int i = 0; i < 8; ++i) wr[i] = (f32x4){1.f, 2.f, 3.f, 4.f}; }
    const unsigned wvoff = (unsigned)((kq * D + 4 * n4) * 4);
#define W2_LOAD1B(wb_, c, i) if (PM != 3 && PM != 4) { const char* b_ = (const char*)(wb_) + ((size_t)(32 * (i)) * D + (size_t)(c) * 64) * 4; \
        asm volatile("global_load_dwordx4 %0, %1, %2" : "=&v"(wr[i]) : "v"(wvoff), "s"(b_) : "memory"); }
#define W2_LOAD1(c, i) W2_LOAD1B(w2, c, i)
#define W2_STORE1(bufoff, i) if (PM != 4) { u32x2 o; o.x = cvtpk(wr[i][0], wr[i][1]); o.y = cvtpk(wr[i][2], wr[i][3]); *(LAS u32x2*)(wdst + (bufoff) + 32 * (i) * P2B_RS) = o; }
#define W2_WAIT() asm volatile("s_waitcnt vmcnt(0)" : "+v"(wr[0]), "+v"(wr[1]), "+v"(wr[2]), "+v"(wr[3]), "+v"(wr[4]), "+v"(wr[5]), "+v"(wr[6]), "+v"(wr[7]) :: "memory")
    if (!have) {
#pragma unroll
        for (int i = 0; i < 8; ++i) W2_LOAD1(0, i);
        W2_WAIT();
#pragma unroll
        for (int i = 0; i < 8; ++i) W2_STORE1(0, i);
#pragma unroll
        for (int i = 0; i < 8; ++i) W2_LOAD1(1, i);
    }
    LDS_BARRIER();
    __builtin_amdgcn_sched_barrier(0);
#pragma unroll 1
    for (int c = 0; c < 16; ++c) {
        const int cur = (c & 1) * P2B_BUF, nxt = P2B_BUF - cur;
        const bool nxu = (c + 2 >= 16) && (w2n != nullptr);
        const int cn = c + 2 < 16 ? c + 2 : (nxu ? c + 2 - 16 : 15);
        const float* wsel = nxu ? w2n : w2;
        W2_WAIT();
        __builtin_amdgcn_sched_barrier(0);
        if (!active) {
#pragma unroll
            for (int i = 0; i < 8; ++i) W2_STORE1(nxt, i);
#pragma unroll
            for (int i = 0; i < 8; ++i) W2_LOAD1B(wsel, cn, i);
        }
        if (active) {
            const LAS char* rb3 = (const LAS char*)(size_t)(unsigned)launder((int)(size_t)(rbase + (rg << 5)));
            f32x4 acc[4][TPW];
#pragma unroll
            for (int nt = 0; nt < 4; ++nt)
#pragma unroll
                for (int mt = 0; mt < TPW; ++mt) acc[nt][mt] = (f32x4){0.f, 0.f, 0.f, 0.f};
#define B2_READ(dst, g_) { const int ks_ = (g_) >> 2, nt_ = (g_) & 3; \
                const LAS char* bp = (const LAS char*)((unsigned)(size_t)rb3 ^ (nt_ << 5)) + cur + ks_ * 32 * P2B_RS; \
                const s16x4 lo = __builtin_bit_cast(s16x4, __builtin_amdgcn_ds_read_tr16_b64_v4i16((LAS s16x4*)bp)); \
                const s16x4 hi = __builtin_bit_cast(s16x4, __builtin_amdgcn_ds_read_tr16_b64_v4i16((LAS s16x4*)(bp + 4 * P2B_RS))); \
                dst = (bf16x8){lo[0], lo[1], lo[2], lo[3], hi[0], hi[1], hi[2], hi[3]}; }
            bf16x8 bb[3];
            B2_READ(bb[0], 0); B2_READ(bb[1], 1);
#pragma unroll
            for (int g = 0; g < 32; ++g) {
                const int ks = g >> 2, nt = g & 3;
                if (g + 2 < 32) { B2_READ(bb[(g + 2) % 3], g + 2); }
#pragma unroll
                for (int mt = 0; mt < TPW; ++mt) acc[nt][mt] = mfma16(bb[g % 3], hf[mt][ks], acc[nt][mt]);
                if (g < 8) { W2_STORE1(nxt, g); } else if (g < 16) { W2_LOAD1B(wsel, cn, g - 8); }
                __builtin_amdgcn_sched_barrier(0);
            }
#undef B2_READ
            {
                LAS char* stg = lds + 2 * P2B_BUF + wid * (2048 * TPW);
#pragma unroll
                for (int mt = 0; mt < TPW; ++mt)
#pragma unroll
                    for (int nt = 0; nt < 4; ++nt) {
                        int w = __builtin_amdgcn_cvt_pk_fp8_f32(acc[nt][mt][0] * YSCALE, acc[nt][mt][1] * YSCALE, 0, false);
                        w = __builtin_amdgcn_cvt_pk_fp8_f32(acc[nt][mt][2] * YSCALE, acc[nt][mt][3] * YSCALE, w, true);
                        *(LAS int*)(stg + (mt * 16 + r) * 128 + ((((c & 1) * 4 + nt) ^ (r & 7)) << 4) + q * 4) = w;
                    }
                if (c & 1) {
                    asm volatile("s_waitcnt lgkmcnt(0)" ::: "memory");
#pragma unroll
                    for (int rr = 0; rr < 2 * TPW; ++rr) {
                        const int srow = rr * 8 + (lane >> 3), row = TPW * wid * 16 + srow;
                        const u32x4 v = *(const LAS u32x4*)(stg + srow * 128 + (((lane & 7) ^ (srow & 7)) << 4));
                        if (PM != 6 && row < rows) *(u32x4*)((PM ? (unsigned char*)p.Ob + (size_t)((base + row0 + row) & 1023) * D : p.Y8 + (size_t)yslot[rr] * D) + (c >> 1) * 128 + (lane & 7) * 16) = v;
                    }
                }
            }
        }
        __builtin_amdgcn_sched_barrier(0);
        LDS_BARRIER();
    }
    W2_WAIT();
#undef W2_LOAD1B
#undef W2_LOAD1
#undef W2_STORE1
#undef W2_WAIT
}
__device__ __forceinline__ void gemm2_wprologue(const float* __restrict__ w2, LAS char* lds, int tid_in, f32x4 (&wr)[8]) {
    const int tid = launder(tid_in);
    const int n4 = tid & 15, kq = tid >> 4;
    LAS char* wdst = lds + kq * P2B_RS + (((n4 >> 2) ^ p2b_g(kq)) << 5) + (n4 & 3) * 8;
    const unsigned wvoff = (unsigned)((kq * D + 4 * n4) * 4);
#define WP_LOAD(c) { _Pragma("unroll") for (int i = 0; i < 8; ++i) { const char* b_ = (const char*)w2 + ((size_t)(32 * i) * D + (size_t)(c) * 64) * 4; \
        asm volatile("global_load_dwordx4 %0, %1, %2" : "=&v"(wr[i]) : "v"(wvoff), "s"(b_) : "memory"); } }
#define WP_WAIT() asm volatile("s_waitcnt vmcnt(0)" : "+v"(wr[0]), "+v"(wr[1]), "+v"(wr[2]), "+v"(wr[3]), "+v"(wr[4]), "+v"(wr[5]), "+v"(wr[6]), "+v"(wr[7]) :: "memory")
    WP_LOAD(0); WP_WAIT();
#pragma unroll
    for (int i = 0; i < 8; ++i) { u32x2 o; o.x = cvtpk(wr[i][0], wr[i][1]); o.y = cvtpk(wr[i][2], wr[i][3]); *(LAS u32x2*)(wdst + 32 * i * P2B_RS) = o; }
    WP_LOAD(1); WP_WAIT();
#undef WP_LOAD
#undef WP_WAIT
}
template <int PM>
__device__ __forceinline__ void phase2b(const Params& p, int l, LAS char* lds, bool pend  ) {
    const int tid = threadIdx.x;
    LAS int* basel = (LAS int*)(lds + LDS_BASE);
    LAS int* ubl = (LAS int*)(lds + LDS_MISC);
    const int* cnt = p.cnt + l * NE;
    expert_bases(cnt, basel, tid);
    if (tid < 64) {
        const int4 c = *(const int4*)(cnt + 4 * launder(tid));
        const int u0 = (c.x + 383) / 384, u1 = (c.y + 383) / 384, u2 = (c.z + 383) / 384, u3 = (c.w + 383) / 384;
        const int s4 = u0 + u1 + u2 + u3; int inc = s4;
#pragma unroll
        for (int o = 1; o < 64; o <<= 1) { const int t = __shfl_up(inc, o); if (tid >= o) inc += t; }
        const int ex = inc - s4;
        ubl[4 * tid] = ex; ubl[4 * tid + 1] = ex + u0; ubl[4 * tid + 2] = ex + u0 + u1; ubl[4 * tid + 3] = ex + u0 + u1 + u2;
        if (tid == 63) ubl[256] = inc;
    }
    __syncthreads();
    const int nunits = ubl[256];
    const int vc = (gridDim.x == 256) ? ((blockIdx.x & 7) * 32 + (blockIdx.x >> 3)) : blockIdx.x;
    f32x4 wr[8];
#pragma unroll
    for (int i = 0; i < 8; ++i) asm volatile("" : "=v"(wr[i]));
    bool have = false;
    if (pend) {
        if (PM == 0 && vc < nunits) {
            int lo0 = 0, hi0 = NE - 1;
            while (lo0 < hi0) { const int mid = (lo0 + hi0 + 1) >> 1; if (ubl[mid] <= vc) lo0 = mid; else hi0 = mid - 1; }
            gemm2_wprologue(p.w_down + ((size_t)l * NE + __builtin_amdgcn_readfirstlane(lo0)) * FE * D, lds, tid, wr);
            have = true;
        }
        grid_wait(p.bar, lds);
    }
    for (int u = vc; u < nunits; u += gridDim.x) {
        int lo = 0, hi = NE - 1;
        while (lo < hi) { const int mid = (lo + hi + 1) >> 1; if (ubl[mid] <= u) lo = mid; else hi = mid - 1; }
        const float* w2n = nullptr;
        { const int un = u + (int)gridDim.x;
          if (un < nunits) { int lo2 = 0, hi2 = NE - 1; while (lo2 < hi2) { const int mid = (lo2 + hi2 + 1) >> 1; if (ubl[mid] <= un) lo2 = mid; else hi2 = mid - 1; }
                             w2n = p.w_down + ((size_t)l * NE + __builtin_amdgcn_readfirstlane(lo2)) * FE * D; } }
        const int e = lo, c = cnt[e], nblk = (c + 383) / 384, k = u - ubl[e];
        const int rpb = ((((c + nblk - 1) / nblk) + 15) >> 4) << 4;
        const int row0 = k * rpb, rows = (c - row0 < rpb) ? (c - row0) : rpb;
        if (rows > 0) {
            const int tpw = (((rows + 15) >> 4) + 7) >> 3;
            const int bs = basel[e];
            if (tpw == 1) gemm2_block<PM, 1>(p, l, e, bs, row0, rows, lds, tid, w2n, have, wr);
            else if (tpw == 2) gemm2_block<PM, 2>(p, l, e, bs, row0, rows, lds, tid, w2n, have, wr);
            else gemm2_block<PM, 3>(p, l, e, bs, row0, rows, lds, tid, w2n, have, wr);
            have = w2n != nullptr;
        } else have = false;
        __syncthreads();
    }
}

template <bool FINAL>
__device__ __forceinline__ void phase3(const Params& p, int l, LAS char* lds, bool pend  ) {
    LAS char* panel = lds + LDS_PANEL; LAS float* red = (LAS float*)(lds + LDS_RED); LAS int* basel = (LAS int*)(lds + LDS_BASE);
    const bf16_t* xin = l ? p.x3 : p.x1;
    expert_bases(p.cnt + l * NE, basel, threadIdx.x);
    for (int tile = blockIdx.x; tile < NTILE; tile += gridDim.x) {
        const int tid = launder(threadIdx.x), wid = __builtin_amdgcn_readfirstlane(tid >> 6), lane = tid & 63, r = lane & 15, q = lane >> 4;
        const int t0 = tile * 64;
        load_panel(xin + (size_t)t0 * D, panel, tid);
#define P3_COMBINE() { \
        _Pragma("unroll 1") \
        for (int i = 0; i < 8; i += 2) { \
            u32x4 xv[2][2], yv[2][TOPK]; \
        _Pragma("unroll") \
            for (int u = 0; u < 2; ++u) { \
                const int t = t0 + wid * 8 + i + u; \
                xv[u][0] = *(const u32x4*)(xin + (size_t)t * D + lane * 16); xv[u][1] = *(const u32x4*)(xin + (size_t)t * D + lane * 16 + 8); \
        _Pragma("unroll") \
                for (int k = 0; k < TOPK; ++k) yv[u][k] = *(const u32x4*)(p.Y8 + (size_t)(t * TOPK + k) * D + lane * 16); \
            } \
        _Pragma("unroll") \
            for (int u = 0; u < 2; ++u) { \
                const int t = t0 + wid * 8 + i + u; \
        _Pragma("unroll") \
                for (int h = 0; h < 2; ++h) { \
                    u32x4 o; \
        _Pragma("unroll") \
                    for (int c2 = 0; c2 < 2; ++c2) { \
                        const int c = 2 * h + c2; \
                        float s0 = 0.f, s1 = 0.f, s2 = 0.f, s3 = 0.f; \
        _Pragma("unroll") \
                        for (int k = 0; k < TOPK; ++k) { \
                            const f32x2_t lo = __builtin_amdgcn_cvt_pk_f32_fp8((int)yv[u][k][c], false), hi = __builtin_amdgcn_cvt_pk_f32_fp8((int)yv[u][k][c], true); \
                            s0 += lo[0]; s1 += lo[1]; s2 += hi[0]; s3 += hi[1]; \
                        } \
                        const unsigned x01 = xv[u][h][2 * c2], x23 = xv[u][h][2 * c2 + 1]; \
                        o[2 * c2] = cvtpk(fmaf(s0, 1.0f / YSCALE, ALPHA * bf_lo(x01)), fmaf(s1, 1.0f / YSCALE, ALPHA * bf_hi(x01))); \
                        o[2 * c2 + 1] = cvtpk(fmaf(s2, 1.0f / YSCALE, ALPHA * bf_lo(x23)), fmaf(s3, 1.0f / YSCALE, ALPHA * bf_hi(x23))); \
                    } \
                    *(u32x4*)(p.x2 + (size_t)t * D + lane * 16 + h * 8) = o; \
                } \
            } \
        } \
        }
        const bool late = (((int)blockIdx.x >> 3) & 1) != 0;
        if (!late) { if (pend) { grid_wait(p.bar, lds); pend = false; } P3_COMBINE(); }
        __syncthreads();
        f32x4 ua[4][4];
#pragma unroll
        for (int nt = 0; nt < 4; ++nt)
#pragma unroll
            for (int mt = 0; mt < 4; ++mt) ua[nt][mt] = (f32x4){0.f, 0.f, 0.f, 0.f};
        panel_mma<2, 0, 4>(ua, panel, 2048, 0, 32, p.wt_wsgu + (size_t)l * D * 512, (2 * wid) * 32 * 512, 32 * 512, lane);
        panel_mma<2, 2, 4>(ua, panel, 2048, 0, 32, p.wt_wsgu + (size_t)l * D * 512, (16 + 2 * wid) * 32 * 512, 32 * 512, lane);
        __syncthreads();
#pragma unroll
        for (int nt = 0; nt < 2; ++nt)
#pragma unroll
            for (int mt = 0; mt < 4; ++mt) {
                const f32x4 g = ua[nt][mt], u = ua[nt + 2][mt];
                u32x2 o; o.x = cvtpk(siluf_(g[0]) * u[0], siluf_(g[1]) * u[1]); o.y = cvtpk(siluf_(g[2]) * u[2], siluf_(g[3]) * u[3]);
                const int m = mt * 16 + r, n = 32 * wid + nt * 16 + 4 * q;
                *(LAS u32x2*)(panel + m * 512 + (((n >> 3) ^ r) << 4) + (n & 7) * 2) = o;
            }
        __syncthreads();
        if (late) { if (pend) { grid_wait(p.bar, lds); pend = false; } P3_COMBINE(); }
#undef P3_COMBINE
        f32x4 acc[8][4];
#pragma unroll
        for (int nt = 0; nt < 8; ++nt)
#pragma unroll
            for (int mt = 0; mt < 4; ++mt) acc[nt][mt] = (f32x4){0.f, 0.f, 0.f, 0.f};
        panel_mma<4, 0, 8>(acc, panel, 512, 0, 8, p.wt_wsd + (size_t)l * FE * D, (8 * wid) * 8 * 512, 8 * 512, lane);
        panel_mma<4, 4, 8>(acc, panel, 512, 0, 8, p.wt_wsd + (size_t)l * FE * D, (8 * wid + 4) * 8 * 512, 8 * 512, lane);
        const int colbase = 128 * wid;
        __syncthreads();
        load_panel(p.x2 + (size_t)t0 * D, panel, tid);
        __syncthreads();
#pragma unroll
        for (int mt = 0; mt < 4; ++mt) {
#pragma unroll
            for (int nt = 0; nt < 8; ++nt) {
                const int n = colbase + nt * 16 + 4 * q;
                const u32x2 cv = *(const LAS u32x2*)(panel + (mt * 16 + r) * 2048 + (((n >> 3) ^ r) << 4) + (n & 7) * 2);
                acc[nt][mt][0] += bf_lo(cv.x); acc[nt][mt][1] += bf_hi(cv.x); acc[nt][mt][2] += bf_lo(cv.y); acc[nt][mt][3] += bf_hi(cv.y);
            }
#pragma unroll
            for (int nt = 0; nt < 8; ++nt) VPIN(acc[nt][mt]);
            CFENCE();
        }
        float mean[4], rstd[4];
        ln_stats<8>(acc, red, wid, lane, mean, rstd);
        const float* lg = p.ln_g + (l * 2 + 1) * D; const float* lb = p.ln_b + (l * 2 + 1) * D;
#pragma unroll
        for (int nt = 0; nt < 8; ++nt) {
            const int n = colbase + nt * 16 + 4 * q;
            const float4 g4 = *(const float4*)(lg + n), b4 = *(const float4*)(lb + n);
#pragma unroll
            for (int mt = 0; mt < 4; ++mt) {
                const int m = mt * 16 + r;
                const float y0 = (acc[nt][mt][0] - mean[mt]) * rstd[mt] * g4.x + b4.x, y1 = (acc[nt][mt][1] - mean[mt]) * rstd[mt] * g4.y + b4.y;
                const float y2 = (acc[nt][mt][2] - mean[mt]) * rstd[mt] * g4.z + b4.z, y3 = (acc[nt][mt][3] - mean[mt]) * rstd[mt] * g4.w + b4.w;
                if (FINAL) { *(float4*)(p.out + (size_t)(t0 + m) * D + n) = make_float4(y0, y1, y2, y3); }
                else {
                    u32x2 o; o.x = cvtpk(y0, y1); o.y = cvtpk(y2, y3);
                    *(LAS u32x2*)(panel + m * 2048 + (((n >> 3) ^ r) << 4) + (n & 7) * 2) = o;
                }
            }
            CFENCE();
        }
        __syncthreads();
        if (!FINAL) {
            store_panel(p.x2 + (size_t)t0 * D, panel, tid);
#pragma unroll 1
            for (int ps = 0; ps < 3; ++ps) {
                const int lane = launder(tid) & 63, r = lane & 15, q = lane >> 4;
#pragma unroll
                for (int nt = 0; nt < 8; ++nt)
#pragma unroll
                    for (int mt = 0; mt < 4; ++mt) acc[nt][mt] = (f32x4){0.f, 0.f, 0.f, 0.f};
                const bf16_t* wt = (ps < 2) ? p.wt_kvf : p.wt_q;
                const int tb = (ps == 1 ? 64 : 0) + 8 * wid;
                panel_mma<4, 0, 8>(acc, panel, 2048, 0, 32, wt, tb * 32 * 512, 32 * 512, lane);
                panel_mma<4, 4, 8>(acc, panel, 2048, 0, 32, wt, (tb + 4) * 32 * 512, 32 * 512, lane);
                bf16_t* dst = (ps == 0) ? p.Kb : (ps == 1) ? p.Vb : p.Qb;
                const float sc = (ps == 2) ? C2 : 1.0f;
                {
                    LAS char* stg = lds + LDS_STAGE + wid * 2048;
                    float mx0 = 0.f, mx1 = 0.f;
#pragma unroll
                    for (int mt = 0; mt < 4; ++mt) {
                        const int ln = launder(tid) & 63, r2 = ln & 15, q2 = ln >> 4;
                        bf16_t* drow = dst + (size_t)(t0 + mt * 16 + (ln >> 3)) * D + 128 * wid + (ln & 7) * 8;
#pragma unroll
                        for (int hh = 0; hh < 2; ++hh) {
#pragma unroll
                            for (int n2 = 0; n2 < 4; ++n2) {
                                const int nt = hh * 4 + n2;
                                u32x2 o; o.x = cvtpk(acc[nt][mt][0] * sc, acc[nt][mt][1] * sc); o.y = cvtpk(acc[nt][mt][2] * sc, acc[nt][mt][3] * sc);
                                *(LAS u32x2*)(stg + r2 * 128 + (((2 * n2 + (q2 >> 1)) ^ (r2 & 7)) << 4) + (q2 & 1) * 8) = o;
                            }
                            asm volatile("s_waitcnt lgkmcnt(0)" ::: "memory");
#pragma unroll
                            for (int i = 0; i < 2; ++i) {
                                const int srow = i * 8 + (ln >> 3);
                                const u32x4 v = *(const LAS u32x4*)(stg + srow * 128 + (((ln & 7) ^ (srow & 7)) << 4));
                                *(u32x4*)(drow + (size_t)(i * 8) * D + hh * 64) = v;
                                if (ps != 1) {
                                    float ss = 0.f;
#pragma unroll
                                    for (int c = 0; c < 4; ++c) { const float a = bf_lo(v[c]), b2 = bf_hi(v[c]); ss = fmaf(a, a, ss); ss = fmaf(b2, b2, ss); }
                                    ss += __shfl_xor(ss, 1); ss += __shfl_xor(ss, 2); ss += __shfl_xor(ss, 4);
                                    if (hh == 0) mx0 = fmaxf(mx0, ss); else mx1 = fmaxf(mx1, ss);
                                }
                            }
                            asm volatile("s_waitcnt lgkmcnt(0)" ::: "memory");
                        }
                    }
                    if (ps != 1) {
                        mx0 = fmaxf(mx0, __shfl_xor(mx0, 8)); mx0 = fmaxf(mx0, __shfl_xor(mx0, 16)); mx0 = fmaxf(mx0, __shfl_xor(mx0, 32));
                        mx1 = fmaxf(mx1, __shfl_xor(mx1, 8)); mx1 = fmaxf(mx1, __shfl_xor(mx1, 16)); mx1 = fmaxf(mx1, __shfl_xor(mx1, 32));
                        if ((tid & 63) == 0) {
                            const int b = t0 / S;
                            if (ps == 0) { atomicMax(p.kmax2 + b * NH + 2 * wid, __float_as_uint(mx0)); atomicMax(p.kmax2 + b * NH + 2 * wid + 1, __float_as_uint(mx1)); }
                            else { atomicMax(p.qmax2 + (b * NH + 2 * wid) * 16 + ((t0 % S) >> 8), __float_as_uint(mx0)); atomicMax(p.qmax2 + (b * NH + 2 * wid + 1) * 16 + ((t0 % S) >> 8), __float_as_uint(mx1)); }
                        }
                    }
                }
            }
            LAS float* lfs = (LAS float*)(lds + LDS_MISC);
            if (wid == 0) {
                f32x4 fa[1][4];
#pragma unroll
                for (int mt = 0; mt < 4; ++mt) fa[0][mt] = (f32x4){0.f, 0.f, 0.f, 0.f};
                panel_mma<1, 0, 1>(fa, panel, 2048, 0, 32, p.wt_kvf, 128 * 32 * 512, 0, lane);
                const float4 bf4 = *(const float4*)(p.b_f + 4 * q);
#pragma unroll
                for (int mt = 0; mt < 4; ++mt) {
                    f32x4 z = fa[0][mt]; z[0] += bf4.x; z[1] += bf4.y; z[2] += bf4.z; z[3] += bf4.w;
                    f32x4 o;
#pragma unroll
                    for (int i = 0; i < 4; ++i) o[i] = fminf(z[i], 0.f) - log1pf(__expf(-fabsf(z[i])));
                    *(LAS f32x4*)(lfs + (mt * 16 + r) * 16 + 4 * q) = o;
                }
            }
            __syncthreads();
            {
                const int b = t0 / S, s0 = t0 % S, ln = launder(tid) & 63;
#pragma unroll
                for (int hh = 0; hh < 2; ++hh) {
                    const int hd = 2 * wid + hh;
                    float v = lfs[ln * 16 + hd];
#pragma unroll
                    for (int o = 1; o < 64; o <<= 1) { const float t = __shfl_up(v, o); if (ln >= o) v += t; }
                    p.Floc[(size_t)(b * NH + hd) * S + s0 + ln] = v;
                    if (ln == 63) p.Tsum[(b * NH + hd) * 64 + (s0 >> 6)] = v;
                }
            }
            __syncthreads();
        }
    }
    if (pend) grid_wait(p.bar, lds);
}
namespace attn_body {
using bf16=__hip_bfloat16;
using bf16x8=__attribute__((ext_vector_type(8)))short;
using s16x4=__attribute__((ext_vector_type(4)))short;
using f32x16=__attribute__((ext_vector_type(16)))float;
using u32x4=__attribute__((ext_vector_type(4)))unsigned;
using f32x4v=__attribute__((ext_vector_type(4)))float;
constexpr int BATCH=4,NHEAD=16,SEQ=4096,D=64,DM=NHEAD*D;
constexpr int NW=8,QBLK=32,QB=QBLK*NW,KVBLK=64,NQB=SEQ/QB;
constexpr int ATTN_PITCH=DM, ATTN_UNIT_ROWS=QB;
__device__ __forceinline__ int crow(int r,int hi){return (r&3)+8*(r>>2)+4*hi;}
#define SBAR() __builtin_amdgcn_sched_barrier(0)
__device__ __forceinline__ void cmask(f32x16&p0,f32x16&p1,int jb,int qrel,int hi){
  const float NEG=-INFINITY; int kb=64*jb+4*hi;
  #pragma unroll
  for(int r=0;r<16;++r){int kv=kb+(r&3)+8*(r>>2); if(kv>qrel)p0[r]=NEG; if(kv+32>qrel)p1[r]=NEG;}
}

constexpr int NSLOT=3, SLOTB=8192;
constexpr int LDS_K=0, LDS_V=NSLOT*SLOTB, LDS_WS=2*NSLOT*SLOTB, LDS_OST=LDS_WS+NW*64*4, LDS_G=LDS_OST+NW*4096, LDS_BYTES=LDS_G+SEQ*4;
constexpr float C2=0.125f*1.4426950408889634f;
__device__ __forceinline__ void glds16(const void*gsrc,unsigned lds_dst){unsigned keep;
  asm volatile("s_mov_b32 %0, m0\n\ts_mov_b32 m0, %2\n\ts_nop 0\n\tglobal_load_lds_dwordx4 %1, off\n\ts_mov_b32 m0, %0":"=&s"(keep):"v"(gsrc),"s"(lds_dst):"memory");}
__device__ __forceinline__ float max3f(float a,float b,float c){float r;asm("v_max3_f32 %0, %1, %2, %3":"=v"(r):"v"(a),"v"(b),"v"(c));return r;}
__device__ __forceinline__ float max2f(float a,float b){float r;asm("v_max_f32_e32 %0, %1, %2":"=v"(r):"v"(a),"v"(b));return r;}
__device__ __forceinline__ float fadd_s(float a,float b){float r;asm("v_add_f32_e32 %0, %1, %2":"=v"(r):"v"(a),"v"(b));return r;}
__device__ __forceinline__ float fsub_s(float a,float b){float r;asm("v_sub_f32_e32 %0, %1, %2":"=v"(r):"v"(a),"v"(b));return r;}
typedef float f32x2_t __attribute__((ext_vector_type(2))); typedef __bf16 bf16x2_t __attribute__((ext_vector_type(2)));
__device__ __forceinline__ unsigned cvtpk_s(float lo,float hi){f32x2_t v={lo,hi};bf16x2_t b=__builtin_convertvector(v,bf16x2_t);return __builtin_bit_cast(unsigned,b);}
#define WAIT_BAR(N) asm volatile("s_waitcnt vmcnt(" #N ") lgkmcnt(0)\n\ts_barrier":::"memory")

__device__ __forceinline__ void qkt(f32x16&p0,f32x16&p1,const char*Kslot,const bf16x8*qr,int r32,int hi){
  const char*kb=Kslot+hi*1024+r32*16;
  #pragma unroll
  for(int d0=0;d0<4;++d0){
    const bf16x8 b0=*reinterpret_cast<const bf16x8*>(kb+d0*2048);
    const bf16x8 b1=*reinterpret_cast<const bf16x8*>(kb+d0*2048+512);
    p0=__builtin_amdgcn_mfma_f32_32x32x16_bf16(b0,qr[d0],p0,0,0,0);p1=__builtin_amdgcn_mfma_f32_32x32x16_bf16(b1,qr[d0],p1,0,0,0);}
}
typedef __attribute__((address_space(3))) const char* lds_cptr;
typedef short v4i16_t __attribute__((ext_vector_type(4)));
__device__ __forceinline__ void kload8(bf16x8*kf,lds_cptr kp){
  kf[0]=*(const __attribute__((address_space(3))) bf16x8*)(kp);      kf[1]=*(const __attribute__((address_space(3))) bf16x8*)(kp+512);
  kf[2]=*(const __attribute__((address_space(3))) bf16x8*)(kp+2048); kf[3]=*(const __attribute__((address_space(3))) bf16x8*)(kp+2560);
  kf[4]=*(const __attribute__((address_space(3))) bf16x8*)(kp+4096); kf[5]=*(const __attribute__((address_space(3))) bf16x8*)(kp+4608);
  kf[6]=*(const __attribute__((address_space(3))) bf16x8*)(kp+6144); kf[7]=*(const __attribute__((address_space(3))) bf16x8*)(kp+6656);
}
__device__ __forceinline__ void kload2(bf16x8*kf,lds_cptr kp,int j){ kf[2*j]=*(const __attribute__((address_space(3))) bf16x8*)(kp+j*2048); kf[2*j+1]=*(const __attribute__((address_space(3))) bf16x8*)(kp+j*2048+512); }
__device__ __forceinline__ s16x4 vtr(lds_cptr p){ return __builtin_bit_cast(s16x4,__builtin_amdgcn_ds_read_tr16_b64_v4i16((__attribute__((address_space(3))) v4i16_t*)p)); }
__device__ __forceinline__ float rowmax(const f32x16&p0,const f32x16&p1){
  float a=max3f(p0[0],p0[1],p1[0]),b=max3f(p0[2],p0[3],p1[1]);a=max3f(a,p1[2],p1[3]);
  #pragma unroll
  for(int r=4;r<16;r+=4){a=max3f(a,p0[r],p0[r+1]);b=max3f(b,p0[r+2],p0[r+3]);a=max3f(a,p1[r],p1[r+1]);b=max3f(b,p1[r+2],p1[r+3]);}
  const float m=max2f(a,b);
  auto rr=__builtin_amdgcn_permlane32_swap(__float_as_uint(m),__float_as_uint(m),false,false);
  return max2f(__uint_as_float(rr[0]),__uint_as_float(rr[1]));
}
__device__ __forceinline__ void pv(f32x16*o,int vb,bf16x8 pa0,bf16x8 pa1,bf16x8 pa2,bf16x8 pa3){
  #pragma unroll
  for(int d0=0;d0<2;++d0){s16x4 lo[4],hi[4];
    #pragma unroll
    for(int ks=0;ks<4;++ks){
      asm volatile("ds_read_b64_tr_b16 %0,%1 offset:%c2":"=&v"(lo[ks]):"v"(vb),"i"(d0*4096+ks*1024):"memory");
      asm volatile("ds_read_b64_tr_b16 %0,%1 offset:%c2":"=&v"(hi[ks]):"v"(vb),"i"(d0*4096+ks*1024+512):"memory");}
    asm volatile("s_waitcnt lgkmcnt(0)":::"memory");SBAR();
    #define PK(k) (bf16x8){lo[k][0],lo[k][1],lo[k][2],lo[k][3],hi[k][0],hi[k][1],hi[k][2],hi[k][3]}
    o[d0]=__builtin_amdgcn_mfma_f32_32x32x16_bf16(pa0,PK(0),o[d0],0,0,0);
    o[d0]=__builtin_amdgcn_mfma_f32_32x32x16_bf16(pa1,PK(1),o[d0],0,0,0);
    o[d0]=__builtin_amdgcn_mfma_f32_32x32x16_bf16(pa2,PK(2),o[d0],0,0,0);
    o[d0]=__builtin_amdgcn_mfma_f32_32x32x16_bf16(pa3,PK(3),o[d0],0,0,0);
    #undef PK
  }
}

#ifndef ATTN_STORE16
#define ATTN_STORE16(p,v) (*(u32x4*)(p)=(v))
#endif
template<int THRL> __device__ __forceinline__ void attn_unit(int b,int h,int qb,const bf16*Q,const bf16*__restrict__ K,const bf16*__restrict__ V,bf16*O,const float*__restrict__ Floc,const float*__restrict__ Tsum,const unsigned*__restrict__ kmax2,const unsigned*__restrict__ qmax2,char*shm){
  const int tid=launder((int)threadIdx.x),lane=tid&63,r32=lane&31,hi=lane>>5; const int wid=__builtin_amdgcn_readfirstlane(tid>>6);
  const long rowbase=(long)b*SEQ; const int q0=qb*QB;
  typedef __attribute__((address_space(3))) float* lds_fptr; typedef __attribute__((address_space(3))) const f32x4v* lds_f4ptr;
  const lds_fptr Gs=(lds_fptr)((__attribute__((address_space(3))) char*)shm+LDS_G);
  { float tv=Tsum[(b*NHEAD+h)*64+lane]; float inc=tv;
    #pragma unroll
    for(int o=1;o<64;o<<=1){const float t_=__shfl_up(inc,o); if(lane>=o)inc+=t_;}
    const float ex=inc-tv; const float*fl=Floc+(long)(b*NHEAD+h)*SEQ;
    for(int j0=0;j0<q0+QB;j0+=NW*64){ const int j=j0+tid; const float off=__shfl(ex,(j>>6)&63); if(j<q0+QB)Gs[j]=(fl[j]+off)*1.4426950408889634f; }
    __syncthreads(); }
  int t0s=0;
  { const float qk=sqrtf(__uint_as_float(qmax2[(b*NHEAD+h)*16+qb]))*sqrtf(__uint_as_float(kmax2[b*NHEAD+h]))*1.02f+1.0f;
    const float thr=-150.f-qk-Gs[q0];
    int lo=0,hi=(q0+QB)/KVBLK-4;
    while(lo<hi){ const int mid=(lo+hi)>>1; if(-Gs[64*mid+63]>=thr)hi=mid; else lo=mid+1; }
    t0s=lo&~1; }
  const bf16*Qw=Q+(rowbase+q0+wid*QBLK)*DM+h*D;
  const bf16*Kh=K+(rowbase+(long)t0s*KVBLK)*DM+h*D,*Vh=V+(rowbase+(long)t0s*KVBLK)*DM+h*D;
  const lds_fptr Gst=Gs+64*t0s;
  const unsigned lds0=(unsigned)(uintptr_t)shm;
  float*wsf=(float*)(shm+LDS_WS)+wid*64;
  const bf16*ksrc=Kh+(long)lane*DM+wid*8;
  const bf16*vsrc=Vh+(long)(16*(wid&3)+(lane>>2))*DM+(wid>>2)*32+(lane&3)*8;
  const unsigned kdst=lds0+LDS_K+wid*1024, vdst=lds0+LDS_V+wid*1024;
  #define DMA_K(t,slot) glds16(ksrc+(long)(t)*KVBLK*DM,(unsigned)__builtin_amdgcn_readfirstlane(kdst+(slot)))
  #define DMA_V(t,slot) glds16(vsrc+(long)(t)*KVBLK*DM,(unsigned)__builtin_amdgcn_readfirstlane(vdst+(slot)))
  const int vb0=(int)(lds0+LDS_V)+((lane>>4)&1)*32+(lane&3)*8+(4*hi+((lane&15)>>2))*64;
  const char*Kbase=shm+LDS_K; bf16x8 kf[8];
  const lds_cptr shm3=(lds_cptr)shm; const lds_cptr kp0=shm3+LDS_K+hi*1024+r32*16; const lds_cptr vp0=shm3+LDS_V+((lane>>4)&1)*32+(lane&3)*8+(4*hi+((lane&15)>>2))*64;
  const int NT=(q0+QB)/KVBLK-t0s;
  DMA_K(0,0);DMA_V(0,0);DMA_K(1,SLOTB);
  bf16x8 qr[4];
  #pragma unroll
  for(int d0=0;d0<4;++d0)qr[d0]=*reinterpret_cast<const bf16x8*>(&Qw[(long)r32*DM+d0*16+hi*8]);
  const int qrel=wid*QBLK+r32;
  const float gi=Gs[q0+qrel];
  float mhat=0.f,l_reg=0.f;f32x16 o[2];o[0]=f32x16{};o[1]=f32x16{};float cinit=gi;
  #define BINIT(P0,P1,t) do{ const lds_f4ptr gp_=(lds_f4ptr)(Gst+64*(t)+4*hi); \
    _Pragma("unroll") for(int g_=0;g_<4;++g_){ const f32x4v a_=gp_[2*g_]; \
      _Pragma("unroll") for(int i_=0;i_<4;++i_) P0[4*g_+i_]=a_[i_]; } \
    _Pragma("unroll") for(int g_=0;g_<4;++g_){ const f32x4v b_=gp_[2*g_+8]; \
      _Pragma("unroll") for(int i_=0;i_<4;++i_) P1[4*g_+i_]=b_[i_]; } \
    _Pragma("unroll") for(int r_=0;r_<16;++r_){ P0[r_]=cinit-P0[r_]; P1[r_]=cinit-P1[r_]; } }while(0)
  #define CMASK(P0,P1,t) do{int jb_=(t)-(NT-4); if(jb_>=0)cmask(P0,P1,jb_,qrel,hi);}while(0)
  bool resc=false;
  #define START(P0,P1) do{ const float rm=rowmax(P0,P1); resc=false; \
    { const float dl=__builtin_fmaxf(rm,0.f); mhat=fadd_s(mhat,dl); \
      _Pragma("unroll") for(int r=0;r<16;++r){P0[r]=fsub_s(P0[r],dl);P1[r]=fsub_s(P1[r],dl);} \
      cinit=gi-mhat; } \
    _Pragma("unroll") for(int r=0;r<16;++r)P0[r]=__builtin_amdgcn_exp2f(P0[r]); }while(0)
  #define RESC() do{ if(resc){ asm volatile("s_waitcnt lgkmcnt(0)":::"memory"); \
      _Pragma("unroll") for(int d_=0;d_<2;++d_) _Pragma("unroll") for(int r=0;r<16;++r)o[d_][r]*=wsf[crow(r,hi)]; } }while(0)
  f32x16 pA0,pA1,pB0,pB1;
  int sl_prev=0,sl_cur=0,sl_next=SLOTB;
  #define ROT() do{sl_prev=sl_cur;sl_cur=sl_next;sl_next=(sl_next==(NSLOT-1)*SLOTB)?0:sl_next+SLOTB;}while(0)
  DMA_K(2,2*SLOTB);
  WAIT_BAR(3);
  BINIT(pA0,pA1,0); qkt(pA0,pA1,Kbase,qr,r32,hi);asm volatile("s_nop 15\n\ts_nop 7":"+v"(pA0),"+v"(pA1));CMASK(pA0,pA1,0);
  START(pA0,pA1);
  _Pragma("unroll") for(int r=0;r<16;++r)pA1[r]=__builtin_amdgcn_exp2f(pA1[r]);
  WAIT_BAR(0);
  DMA_K(3,0);DMA_V(1,SLOTB);
  ROT();
  kload8(kf,kp0+sl_cur);
  WAIT_BAR(2);
  s16x4 vlo[8],vhi[8]; u32x4 pw0,pw1,pw2,pw3;
  #define PKW(P,B) cvtpk_s(P[B],P[B+1])
  #define PAF(k) __builtin_bit_cast(bf16x8,pw##k)
  #define VFR(i) (bf16x8){vlo[i][0],vlo[i][1],vlo[i][2],vlo[i][3],vhi[i][0],vhi[i][1],vhi[i][2],vhi[i][3]}
  #define PIN(x) asm volatile("":"+v"(x))
  #define MX3(a,b,c) __builtin_fmaxf(__builtin_fmaxf((a),(b)),(c))
  #define GAPA(MF,A0,A1,A2,A3,W0,W1,PW) do{ MF; sacc+=A0; sacc+=A1; sacc+=A2; sacc+=A3; PIN(sacc); W0; W1; PIN(PW); SBAR(); }while(0)
  #define EX(v) __builtin_amdgcn_exp2f(v)
  #define GAPB(MF,X,B) do{ MF; X[B]=EX(X[B]); X[B+1]=EX(X[B+1]); X[B+2]=EX(X[B+2]); X[B+3]=EX(X[B+3]); PIN(X); SBAR(); }while(0)
  #define VRD(i) do{ vlo[i]=vtr(vp_+(((i)>>2)*4096+((i)&3)*1024)); vhi[i]=vtr(vp_+(((i)>>2)*4096+((i)&3)*1024+512)); }while(0)
  #define KRD(G,j) do{ if(G){ kload2(kf,kp0+sl_next,j); SBAR(); } }while(0)
  #define STEP(C0,C1,P0,P1,t,GK,GV,GL) do{ SBAR(); BINIT(C0,C1,t); SBAR(); \
    const lds_cptr vp_=vp0+sl_prev; \
    VRD(0); SBAR(); float sacc=(P0[0]+P0[1]); \
    GAPA(C0=__builtin_amdgcn_mfma_f32_32x32x16_bf16(kf[0],qr[0],C0,0,0,0), P0[2],P0[3],P0[4],P0[5],     pw0[0]=PKW(P0,0), pw0[1]=PKW(P0,2), pw0); \
    VRD(4); SBAR(); GAPA(C1=__builtin_amdgcn_mfma_f32_32x32x16_bf16(kf[1],qr[0],C1,0,0,0), P0[6],P0[7],P0[8],P0[9],     pw0[2]=PKW(P0,4), pw0[3]=PKW(P0,6), pw0); \
    VRD(1); SBAR(); GAPA(C0=__builtin_amdgcn_mfma_f32_32x32x16_bf16(kf[2],qr[1],C0,0,0,0),   P0[10],P0[11],P0[12],P0[13], pw1[0]=PKW(P0,8), pw1[1]=PKW(P0,10), pw1); \
    VRD(5); SBAR(); GAPA(C1=__builtin_amdgcn_mfma_f32_32x32x16_bf16(kf[3],qr[1],C1,0,0,0),   P0[14],P0[15],P1[0],P1[1],   pw1[2]=PKW(P0,12),pw1[3]=PKW(P0,14), pw1); \
    VRD(2); SBAR(); GAPA(C0=__builtin_amdgcn_mfma_f32_32x32x16_bf16(kf[4],qr[2],C0,0,0,0),   P1[2],P1[3],P1[4],P1[5],     pw2[0]=PKW(P1,0), pw2[1]=PKW(P1,2), pw2); \
    VRD(6); SBAR(); GAPA(C1=__builtin_amdgcn_mfma_f32_32x32x16_bf16(kf[5],qr[2],C1,0,0,0),   P1[6],P1[7],P1[8],P1[9],     pw2[2]=PKW(P1,4), pw2[3]=PKW(P1,6), pw2); \
    VRD(3); SBAR(); GAPA(C0=__builtin_amdgcn_mfma_f32_32x32x16_bf16(kf[6],qr[3],C0,0,0,0),   P1[10],P1[11],P1[12],P1[13], pw3[0]=PKW(P1,8), pw3[1]=PKW(P1,10), pw3); \
    VRD(7); SBAR(); GAPA(C1=__builtin_amdgcn_mfma_f32_32x32x16_bf16(kf[7],qr[3],C1,0,0,0),   P1[14],P1[15],0.f,0.f,       pw3[2]=PKW(P1,12),pw3[3]=PKW(P1,14), pw3); \
    l_reg+=sacc; \
    if(GK){DMA_K((t)+3,sl_cur);} if(GV){DMA_V((t)+1,sl_next);} \
    CMASK(C0,C1,t); \
    { float a=MX3(C0[0],C0[1],C1[0]),b=MX3(C0[2],C0[3],C1[1]); a=MX3(a,C1[2],C1[3]); \
      _Pragma("unroll") for(int r=4;r<16;r+=4){a=MX3(a,C0[r],C0[r+1]);b=MX3(b,C0[r+2],C0[r+3]);a=MX3(a,C1[r],C1[r+1]);b=MX3(b,C1[r+2],C1[r+3]);} \
      float rm=__builtin_fmaxf(a,b); { auto rr=__builtin_amdgcn_permlane32_swap(__float_as_uint(rm),__float_as_uint(rm),false,false); rm=__builtin_fmaxf(__uint_as_float(rr[0]),__uint_as_float(rr[1])); } \
      resc=false; \
      if(__builtin_expect(__any(rm>(float)THRL),0)){ const float dl=__builtin_fmaxf(rm,0.f); mhat+=dl; \
        _Pragma("unroll") for(int r=0;r<16;++r){C0[r]-=dl;C1[r]-=dl;} \
        cinit=gi-mhat; \
        const float f=__builtin_amdgcn_exp2f(-dl); l_reg*=f; if(hi==0)wsf[r32]=f; resc=true; } } \
    SBAR(); \
    GAPB(o[0]=__builtin_amdgcn_mfma_f32_32x32x16_bf16(PAF(0),VFR(0),o[0],0,0,0), C0,0); \
    GAPB(o[1]=__builtin_amdgcn_mfma_f32_32x32x16_bf16(PAF(0),VFR(4),o[1],0,0,0), C0,4); \
    KRD(GL,0); GAPB(o[0]=__builtin_amdgcn_mfma_f32_32x32x16_bf16(PAF(1),VFR(1),o[0],0,0,0), C0,8); \
    KRD(GL,1); GAPB(o[1]=__builtin_amdgcn_mfma_f32_32x32x16_bf16(PAF(1),VFR(5),o[1],0,0,0), C0,12); \
    KRD(GL,2); GAPB(o[0]=__builtin_amdgcn_mfma_f32_32x32x16_bf16(PAF(2),VFR(2),o[0],0,0,0), C1,0); \
    KRD(GL,3); GAPB(o[1]=__builtin_amdgcn_mfma_f32_32x32x16_bf16(PAF(2),VFR(6),o[1],0,0,0), C1,4); \
    GAPB(o[0]=__builtin_amdgcn_mfma_f32_32x32x16_bf16(PAF(3),VFR(3),o[0],0,0,0), C1,8); \
    GAPB(o[1]=__builtin_amdgcn_mfma_f32_32x32x16_bf16(PAF(3),VFR(7),o[1],0,0,0), C1,12); \
    }while(0)
  int t=1;
  #undef CMASK
  #define CMASK(P0,P1,t) do{}while(0)
  for(;t+5<NT;t+=2){
    STEP(pB0,pB1,pA0,pA1,t,true,true,true);     WAIT_BAR(2); RESC(); ROT();
    STEP(pA0,pA1,pB0,pB1,t+1,true,true,true);   WAIT_BAR(2); RESC(); ROT();
  }
  #undef CMASK
  #define CMASK(P0,P1,t) do{int jb_=(t)-(NT-4); if(jb_>=0)cmask(P0,P1,jb_,qrel,hi);}while(0)
  #define ENDW(tt) do{ if((tt)+3<NT){WAIT_BAR(2);} else if((tt)+2<NT){WAIT_BAR(1);} else {WAIT_BAR(0);} }while(0)
  for(;t+1<NT;t+=2){
    STEP(pB0,pB1,pA0,pA1,t,(t+3<NT),(t+1<NT),(t+1<NT));       ENDW(t);   RESC(); ROT();
    STEP(pA0,pA1,pB0,pB1,t+1,(t+4<NT),(t+2<NT),(t+2<NT));     ENDW(t+1); RESC(); ROT();
  }
  STEP(pB0,pB1,pA0,pA1,NT-1,false,false,false); RESC();
  { float sacc=pB0[0]+pB0[1]; _Pragma("unroll") for(int r=2;r<16;++r)sacc+=pB0[r]; _Pragma("unroll") for(int r=0;r<16;++r)sacc+=pB1[r]; l_reg+=sacc;
    pw0=(u32x4){PKW(pB0,0),PKW(pB0,2),PKW(pB0,4),PKW(pB0,6)};pw1=(u32x4){PKW(pB0,8),PKW(pB0,10),PKW(pB0,12),PKW(pB0,14)};pw2=(u32x4){PKW(pB1,0),PKW(pB1,2),PKW(pB1,4),PKW(pB1,6)};pw3=(u32x4){PKW(pB1,8),PKW(pB1,10),PKW(pB1,12),PKW(pB1,14)};
    SBAR(); pv(o,vb0+sl_cur,PAF(0),PAF(1),PAF(2),PAF(3)); }
  #undef PKW
  #undef PAF
  #undef VFR
  #undef PIN
  #undef MX3
  #undef GAPA
  #undef GAPB
  #undef EX
  #undef VRD
  #undef KRD
  #undef STEP
  #undef ENDW
  {auto rr=__builtin_amdgcn_permlane32_swap(__float_as_uint(l_reg),__float_as_uint(l_reg),false,false);l_reg=__uint_as_float(rr[0])+__uint_as_float(rr[1]);}
  if(hi==0)wsf[32+r32]=l_reg;asm volatile("s_waitcnt lgkmcnt(0)":::"memory");
  float rli[16];
  #pragma unroll
  for(int r=0;r<16;++r)rli[r]=__builtin_amdgcn_rcpf(wsf[32+crow(r,hi)]);
  bf16*Ow=O+(rowbase+q0+wid*QBLK)*DM+h*D;
  { bf16*stg=(bf16*)(shm+LDS_OST)+wid*2048;
    #pragma unroll
    for(int r=0;r<16;++r){const int orow=crow(r,hi);
      #pragma unroll
      for(int d0=0;d0<2;++d0)stg[orow*64+d0*32+r32]=__float2bfloat16(o[d0][r]*rli[r]);}
    asm volatile("s_waitcnt lgkmcnt(0)":::"memory");
    #pragma unroll
    for(int i=0;i<4;++i){const int row=i*8+(lane>>3),ch=lane&7; const u32x4 v=*(const u32x4*)(stg+row*64+ch*8); ATTN_STORE16(Ow+(long)row*DM+ch*8,v);} }
  asm volatile("s_waitcnt lgkmcnt(0)\n\ts_barrier":::"memory");
  #undef DMA_K
  #undef DMA_V
  #undef CMASK
  #undef START
  #undef RESC
  #undef ROT
  #undef BINIT
}
constexpr int ATTN_LDS_BYTES=LDS_BYTES;
#undef SBAR
#undef WAIT_BAR
}


__device__ __forceinline__ void phase4(const Params& p, LAS char* lds) {
    char* shm = (char*)lds;
    const int bid = blockIdx.x;
    for (int v0 = bid; v0 < 256; v0 += gridDim.x) {
        const int v = (gridDim.x == 256) ? ((v0 & 7) * 32 + (v0 >> 3)) : v0;
        const int bh = v >> 2, s = v & 3;
#pragma unroll 1
        for (int i = 0; i < 4; ++i) {
            const int qb = (i == 0) ? s : (i == 1) ? 7 - s : (i == 2) ? 8 + s : 15 - s;
            attn_body::attn_unit<8>(bh / NH, bh % NH, qb, (const attn_body::bf16*)p.Qb, (const attn_body::bf16*)p.Kb, (const attn_body::bf16*)p.Vb, (attn_body::bf16*)p.Ob, p.Floc, p.Tsum, p.kmax2, p.qmax2, shm);
        }
    }
}
__device__ __forceinline__ void phase5(const Params& p, LAS char* lds) {
    LAS char* panel = lds + LDS_PANEL;
    for (int tile = blockIdx.x; tile < NTILE; tile += gridDim.x) {
        const int tid = launder(threadIdx.x), wid = __builtin_amdgcn_readfirstlane(tid >> 6), lane = tid & 63, r = lane & 15, q = lane >> 4;
        const int t0 = tile * 64;
        load_panel(p.Ob + (size_t)t0 * D, panel, tid);
        __syncthreads();
        f32x4 acc[8][4];
#pragma unroll
        for (int nt = 0; nt < 8; ++nt)
#pragma unroll
            for (int mt = 0; mt < 4; ++mt) acc[nt][mt] = (f32x4){0.f, 0.f, 0.f, 0.f};
        panel_mma<4, 0, 8>(acc, panel, 2048, 0, 32, p.wt_o, (8 * wid) * 32 * 512, 32 * 512, lane);
        panel_mma<4, 4, 8>(acc, panel, 2048, 0, 32, p.wt_o, (8 * wid + 4) * 32 * 512, 32 * 512, lane);
        const int colbase = 128 * wid;
        __syncthreads();
        load_panel(p.x2 + (size_t)t0 * D, panel, tid);
        __syncthreads();
#pragma unroll
        for (int mt = 0; mt < 4; ++mt) {
#pragma unroll
            for (int nt = 0; nt < 8; ++nt) {
                const int n = colbase + nt * 16 + 4 * q;
                const u32x2 cv = *(const LAS u32x2*)(panel + (mt * 16 + r) * 2048 + (((n >> 3) ^ r) << 4) + (n & 7) * 2);
                acc[nt][mt][0] = fmaf(ALPHA, bf_lo(cv.x), acc[nt][mt][0]); acc[nt][mt][1] = fmaf(ALPHA, bf_hi(cv.x), acc[nt][mt][1]);
                acc[nt][mt][2] = fmaf(ALPHA, bf_lo(cv.y), acc[nt][mt][2]); acc[nt][mt][3] = fmaf(ALPHA, bf_hi(cv.y), acc[nt][mt][3]);
            }
#pragma unroll
            for (int nt = 0; nt < 8; ++nt) VPIN(acc[nt][mt]);
            CFENCE();
        }
        ln_route_tail(p, 1, 0, acc, colbase, p.x3, lds, t0, tid);
    }
}

extern __shared__ __attribute__((aligned(16))) unsigned char dyn_lds[];

__global__ void __launch_bounds__(512, 2) k_mega(Params p) {
    LAS char* lds = (LAS char*)dyn_lds;
    if (threadIdx.x == 0) *(LAS u32x4*)(lds + LDS_XB) = (u32x4){0u, 0u, 0u, 0u};
    __syncthreads();
    (void)xcd_barrier_post(p.bar, (volatile LAS unsigned*)(lds + LDS_XB));
#define GRID_BARRIER() do { grid_arrive(p.bar, lds); grid_wait(p.bar, lds); } while (0)
    phase0a(p);                GRID_BARRIER();
    { const bool pre = (((int)blockIdx.x >> 3) & 1) != 0;
      if (pre) phase0b(p); phase1(p, lds); if (!pre) phase0b(p); } GRID_BARRIER();
    phase2a<0>(p, 0, lds);        grid_arrive(p.bar, lds);
    phase2b<0>(p, 0, lds, true);        grid_arrive(p.bar, lds);
    phase3<false>(p, 0, lds, true);  GRID_BARRIER();
    phase4(p, lds);            GRID_BARRIER();
    phase5(p, lds);            GRID_BARRIER();
    phase2a<0>(p, 1, lds);        grid_arrive(p.bar, lds);
    phase2b<0>(p, 1, lds, true);        grid_arrive(p.bar, lds);
    phase3<true>(p, 1, lds, true);
}
}

extern "C" void kernel_launch(void* const* d_in, const int* in_sizes, int n_in, void* d_out, int out_size, void* d_ws, size_t ws_size, hipStream_t stream) {
    using namespace nk;
    Params p{};
    p.x = (const float*)d_in[0]; p.pool_w = (const float*)d_in[1]; p.pool_scale = (const float*)d_in[2]; p.w_q = (const float*)d_in[3]; p.w_o = (const float*)d_in[4];
    p.w_kvf = (const float*)d_in[5]; p.b_f = (const float*)d_in[6]; p.ln_g = (const float*)d_in[7]; p.ln_b = (const float*)d_in[8]; p.router_w = (const float*)d_in[9];
    p.router_b = (const float*)d_in[10]; p.w_gate_up = (const float*)d_in[11]; p.w_down = (const float*)d_in[12]; p.ws_gate_up = (const float*)d_in[13]; p.ws_down = (const float*)d_in[14];
    p.out = (float*)d_out;
    char* ws = (char*)d_ws; size_t off = 0;
    auto alloc = [&](size_t bytes) { void* q = ws + off; off += (bytes + 255) & ~(size_t)255; return q; };
    p.bar = (unsigned*)alloc(16384); p.cnt = (int*)alloc(2 * NE * 4); p.kmax2 = (unsigned*)alloc(64 * 4); p.qmax2 = (unsigned*)alloc(1024 * 4);
    const size_t ctl_bytes = off;
    p.wt_pool = (bf16_t*)alloc(4 * 65536 * 2); p.wt_router = (bf16_t*)alloc((size_t)2 * D * NE * 2); p.wt_wsgu = (bf16_t*)alloc((size_t)2 * D * 512 * 2);
    p.wt_wsd = (bf16_t*)alloc((size_t)2 * FE * D * 2); p.wt_kvf = (bf16_t*)alloc((size_t)D * NKVF * 2); p.wt_q = (bf16_t*)alloc((size_t)D * D * 2); p.wt_o = (bf16_t*)alloc((size_t)D * D * 2);
    p.x1 = (bf16_t*)alloc((size_t)NTOK * D * 2); p.x2 = (bf16_t*)alloc((size_t)NTOK * D * 2); p.x3 = (bf16_t*)alloc((size_t)NTOK * D * 2);
    p.Kb = (bf16_t*)alloc((size_t)NTOK * D * 2); p.Vb = (bf16_t*)alloc((size_t)NTOK * D * 2); p.Qb = (bf16_t*)alloc((size_t)NTOK * D * 2); p.Ob = (bf16_t*)alloc((size_t)NTOK * D * 2);
    p.Floc = (float*)alloc((size_t)NB * NH * S * 4); p.Tsum = (float*)alloc(NB * NH * 64 * 4);
    p.ltok = (int*)alloc((size_t)NE * LCAP * 4); p.lw = (float*)alloc((size_t)NE * LCAP * 4); p.pe = (int*)alloc(NTOK * TOPK * 4); p.pp = (int*)alloc(NTOK * TOPK * 4);
    p.Hb = (bf16_t*)alloc((size_t)NTOK * TOPK * FE * 2); p.Y8 = (unsigned char*)alloc((size_t)NTOK * TOPK * D);
    if (off > ws_size) { fprintf(stderr, "workspace too small: need %zu have %zu\n", off, ws_size); return; }
    static int grid = 0;
    if (!grid) {
        int dev = 0, cus = 0, per_cu = 0;
        (void)hipGetDevice(&dev); (void)hipDeviceGetAttribute(&cus, hipDeviceAttributeMultiprocessorCount, dev);
        (void)hipFuncSetAttribute((const void*)k_mega, hipFuncAttributeMaxDynamicSharedMemorySize, LDS_TOTAL);
        if (hipOccupancyMaxActiveBlocksPerMultiprocessor(&per_cu, (const void*)k_mega, 512, LDS_TOTAL) != hipSuccess || per_cu < 1) { fprintf(stderr, "occupancy query: %d\n", per_cu); per_cu = 1; }
        (void)hipGetLastError();
        grid = cus * 1;
    }
    (void)hipMemsetAsync(ws, 0, ctl_bytes, stream);
    k_mega<<<grid, 512, LDS_TOTAL, stream>>>(p);
}
```
